# Optimizing an MI355X kernel written in HIP

```python
import jax
import jax.numpy as jnp
from jax import lax
import numpy as np

D_MODEL = 1024
BATCH = 1
SEQ = 16384
DEPTH = 4

GRID_W = 64
CTX_LEN = 256
N_MIXERS = 3
N_CONV_LAYERS = (DEPTH + 2) // N_MIXERS
N_RET_LAYERS = (DEPTH + 1) // N_MIXERS
N_ATT_LAYERS = DEPTH // N_MIXERS
CONV_WIDTH = 31
RET_HEADS = 4
RET_QK_DIM = D_MODEL // RET_HEADS
RET_V_DIM = 2 * D_MODEL // RET_HEADS
RET_CHUNK = 128
ATT_Q_HEADS = 16
ATT_KV_HEADS = 4
ATT_HEAD_DIM = 64
ATT_WINDOW = 128
ATT_BLOCK = 128
FFN_HIDDEN = -(-8 * D_MODEL // (3 * 256)) * 256
ROPE_BASE = 10000.0
NORM_EPS = 1e-6
NEG_INF = -1e30

kernel_name = 'hybrid_conv_retention_swa_dit'


def rms_norm(x, g):
    xf = x.astype(jnp.float32)
    y = xf * lax.rsqrt(jnp.mean(xf * xf, axis=-1, keepdims=True) + NORM_EPS)
    return (y * g.astype(jnp.float32)).astype(x.dtype)


def layer_norm(x, g):
    xf = x.astype(jnp.float32)
    xc = xf - jnp.mean(xf, axis=-1, keepdims=True)
    y = xc * lax.rsqrt(jnp.mean(xc * xc, axis=-1, keepdims=True) + NORM_EPS)
    return (y * g.astype(jnp.float32)).astype(x.dtype)


def modulate(x, g, shift, scale):
    return rms_norm(x, g) * (1 + scale) + shift


def adaln(cond, w, b):
    mods = jnp.split(jax.nn.silu(cond) @ w + b, 6, axis=-1)
    return [m[:, None, :] for m in mods]


def grid_positions(T):
    n_rows = T // GRID_W
    rows = jnp.repeat(jnp.arange(n_rows), GRID_W).astype(jnp.float32)
    cols = (jnp.arange(n_rows * GRID_W) % GRID_W).astype(jnp.float32)
    return rows, cols


def _rotate(x, ang):
    m = x.shape[-1] // 2
    cos = jnp.cos(ang)[None, :, None, :]
    sin = jnp.sin(ang)[None, :, None, :]
    x1, x2 = x[..., :m], x[..., m:]
    return jnp.concatenate([x1 * cos - x2 * sin, x2 * cos + x1 * sin], axis=-1)


def axial_rope(x, rows, cols):
    hd = x.shape[-1]
    half, quarter = hd // 2, hd // 4
    inv = ROPE_BASE ** (-jnp.arange(quarter, dtype=jnp.float32) / quarter)
    xf = x.astype(jnp.float32)
    out = jnp.concatenate([_rotate(xf[..., :half], rows[:, None] * inv),
                           _rotate(xf[..., half:], cols[:, None] * inv)], axis=-1)
    return out.astype(x.dtype)


def conv_module(h, w1, b1, dw, dw_b, norm_g, w2):
    y = h @ w1 + b1
    a, gt = jnp.split(y, 2, axis=-1)
    y = a * jax.nn.sigmoid(gt)
    y = lax.conv_general_dilated(
        y, dw[:, None, :].astype(y.dtype), window_strides=(1,),
        padding=[(CONV_WIDTH // 2, CONV_WIDTH // 2)],
        dimension_numbers=('NWC', 'WIO', 'NWC'),
        feature_group_count=D_MODEL) + dw_b
    y = jax.nn.silu(layer_norm(y, norm_g))
    return y @ w2


def retention_chunked(q, k, v, log_gamma, s0):
    B, H, T, dk = q.shape
    dv = v.shape[-1]
    C = RET_CHUNK
    N = T // C
    idx = jnp.arange(C, dtype=jnp.float32)
    rel = idx[:, None] - idx[None, :]
    intra_decay = jnp.where(rel >= 0, jnp.exp(log_gamma[:, None, None] * jnp.maximum(rel, 0.0)), 0.0)
    q_decay = jnp.exp(log_gamma[:, None] * (idx + 1.0))[None, :, :, None]
    k_decay = jnp.exp(log_gamma[:, None] * (C - 1.0 - idx))[None, :, :, None]
    chunk_decay = jnp.exp(log_gamma * C)[None, :, None, None]
    lead = lambda t: jnp.moveaxis(t.reshape(B, H, N, C, t.shape[-1]), 2, 0)

    def step(s, xs):
        qc, kc, vc = xs
        scores = jnp.einsum('bhcd,bhmd->bhcm', qc, kc) * intra_decay
        o = jnp.einsum('bhcm,bhme->bhce', scores, vc) + jnp.einsum('bhcd,bhde->bhce', qc * q_decay, s)
        s = s * chunk_decay + jnp.einsum('bhcd,bhce->bhde', kc * k_decay, vc)
        return s, o

    s_final, o = lax.scan(step, s0, (lead(q), lead(k), lead(v)))
    return jnp.moveaxis(o, 0, 2).reshape(B, H, T, dv), s_final


def retention_state(k, v, log_gamma, reverse):
    L = k.shape[2]
    m = jnp.arange(L, dtype=jnp.float32)
    dist = m if reverse else (L - 1.0 - m)
    w = jnp.exp(log_gamma[:, None] * dist)[None, :, :, None]
    return jnp.einsum('bhld,bhle->bhde', k * w, v)


def retention_mixer(hc, hx, w_in, dec_f, dec_b, w_out, rows, cols, ctx_out):
    H, dk, dv = RET_HEADS, RET_QK_DIM, RET_V_DIM

    def project(h, rope):
        B, T, _ = h.shape
        q, k, v, g = jnp.split(h @ w_in, [H * dk, 2 * H * dk, 2 * H * dk + H * dv], axis=-1)
        q = q.reshape(B, T, H, dk)
        k = k.reshape(B, T, H, dk)
        if rope:
            q = axial_rope(q, rows, cols)
            k = axial_rope(k, rows, cols)
        heads = lambda t: jnp.swapaxes(t.astype(jnp.float32), 1, 2)
        return heads(q), heads(k) * dk ** -0.5, heads(v.reshape(B, T, H, dv)), g

    def readout(o, g):
        B, _, T, _ = o.shape
        o = o * lax.rsqrt(jnp.mean(o * o, axis=-1, keepdims=True) + NORM_EPS)
        o = jnp.swapaxes(o, 1, 2).reshape(B, T, H * dv).astype(g.dtype)
        return (jax.nn.silu(g) * o) @ w_out

    flip = lambda t: jnp.flip(t, axis=2)
    lg_f = jax.nn.log_sigmoid(dec_f.astype(jnp.float32))
    lg_b = jax.nn.log_sigmoid(dec_b.astype(jnp.float32))
    qc, kc, vc, gc = project(hc, False)
    qx, kx, vx, gx = project(hx, True)
    if ctx_out:
        zeros = jnp.zeros((hc.shape[0], H, dk, dv), jnp.float32)
        oc_f, sc_f = retention_chunked(qc, kc, vc, lg_f, zeros)
        oc_b, sc_b = retention_chunked(flip(qc), flip(kc), flip(vc), lg_b, zeros)
        oc = readout(oc_f + flip(oc_b), gc)
    else:
        sc_f = retention_state(kc, vc, lg_f, False)
        sc_b = retention_state(kc, vc, lg_b, True)
        oc = None
    ox_f, _ = retention_chunked(qx, kx, vx, lg_f, sc_f)
    ox_b, _ = retention_chunked(flip(qx), flip(kx), flip(vx), lg_b, sc_b)
    ox = readout(ox_f + flip(ox_b), gx)
    return oc, ox


def attention_mixer(hc, hx, w_qkv, q_gain, k_gain, sink, w_o, rows, cols, ctx_out):
    Hq, Hk, hd = ATT_Q_HEADS, ATT_KV_HEADS, ATT_HEAD_DIM
    G = Hq // Hk

    def project(h, rope):
        B, T, _ = h.shape
        q, k, v = jnp.split(h @ w_qkv, [Hq * hd, (Hq + Hk) * hd], axis=-1)
        q = rms_norm(q.reshape(B, T, Hq, hd), q_gain)
        k = rms_norm(k.reshape(B, T, Hk, hd), k_gain)
        if rope:
            q = axial_rope(q, rows, cols)
            k = axial_rope(k, rows, cols)
        q = (q * hd ** -0.5).reshape(B, T, Hk, G, hd)
        return q, k, v.reshape(B, T, Hk, hd)

    sink_kg = sink.astype(jnp.float32).reshape(Hk, G)[None, :, :, None, None]

    def sink_softmax(parts):
        s_sink = jnp.broadcast_to(sink_kg, parts[0].shape[:-1] + (1,))
        return jax.nn.softmax(jnp.concatenate(parts + [s_sink], axis=-1), axis=-1)

    qc, kc, vc = project(hc, False)
    qx, kx, vx = project(hx, True)
    B, L = hc.shape[0], hc.shape[1]
    T = hx.shape[1]
    C = ATT_BLOCK
    N = T // C

    if ctx_out:
        s = jnp.einsum('bqkgd,bjkd->bkgqj', qc, kc).astype(jnp.float32)
        p = sink_softmax([s])[..., :L].astype(vc.dtype)
        oc = jnp.einsum('bkgqj,bjkd->bqkgd', p, vc).reshape(B, L, Hq * hd) @ w_o
    else:
        oc = None

    pad = lambda t: jnp.pad(t, ((0, 0), (C, C), (0, 0), (0, 0))).reshape(B, N + 2, C, Hk, hd)
    band = lambda tp: jnp.concatenate([tp[:, :-2], tp[:, 1:-1], tp[:, 2:]], axis=2)
    kb = band(pad(kx))
    vb = band(pad(vx))
    qb = qx.reshape(B, N, C, Hk, G, hd)
    a = jnp.arange(C)[:, None]
    j = jnp.arange(3 * C)[None, :]
    key_pos = jnp.arange(N)[:, None, None] * C + (j - C)[None]
    mask = (jnp.abs(j - C - a) <= ATT_WINDOW)[None] & (key_pos >= 0) & (key_pos < T)

    def one_block(args):
        q_n, k_n, v_n, m_n = args
        s_ctx = jnp.einsum('bqkgd,bjkd->bkgqj', q_n, kc).astype(jnp.float32)
        s_band = jnp.where(m_n, jnp.einsum('bqkgd,bjkd->bkgqj', q_n, k_n).astype(jnp.float32), NEG_INF)
        p = sink_softmax([s_ctx, s_band])
        o = jnp.einsum('bkgqj,bjkd->bqkgd', p[..., :L].astype(vc.dtype), vc)
        return o + jnp.einsum('bkgqj,bjkd->bqkgd', p[..., L:L + 3 * C].astype(v_n.dtype), v_n)

    lead = lambda t: jnp.moveaxis(t, 1, 0)
    ob = lax.map(one_block, (lead(qb), lead(kb), lead(vb), mask))
    ox = jnp.moveaxis(ob, 0, 1).reshape(B, T, Hq * hd) @ w_o
    return oc, ox


def swiglu_ffn(h, w_gu, w_down):
    a, b = jnp.split(h @ w_gu, 2, axis=-1)
    return (jax.nn.silu(a) * b) @ w_down


def setup_inputs(seed: int = 0) -> dict:
    key = jax.random.key(seed)
    ks = iter(jax.random.split(key, 32))
    nrm = lambda shape, scale: jax.random.normal(next(ks), shape, jnp.float32) * scale
    D = D_MODEL
    ret_proj = 2 * RET_HEADS * RET_QK_DIM + 2 * RET_HEADS * RET_V_DIM
    att_proj = (ATT_Q_HEADS + 2 * ATT_KV_HEADS) * ATT_HEAD_DIM
    gam = 1.0 - np.exp(np.linspace(np.log(1.0 / 32), np.log(1.0 / 512), RET_HEADS))
    dec_logit = jnp.asarray(np.log(gam / (1.0 - gam)), jnp.float32)
    return {
        'x': nrm((BATCH, SEQ, D), 1.0),
        'c': nrm((BATCH, D), 1.0),
        'ctx': nrm((BATCH, CTX_LEN, D), 1.0),
        'c_ctx': nrm((D,), 1.0),
        'ada_w': nrm((DEPTH, D, 6 * D), 0.5 * D ** -0.5),
        'ada_b': nrm((DEPTH, 6 * D), 0.01),
        'norm_mix': 1.0 + nrm((DEPTH, D), 0.02),
        'norm_ffn': 1.0 + nrm((DEPTH, D), 0.02),
        'conv_w1': nrm((N_CONV_LAYERS, D, 2 * D), D ** -0.5),
        'conv_b1': nrm((N_CONV_LAYERS, 2 * D), 0.01),
        'conv_dw': nrm((N_CONV_LAYERS, CONV_WIDTH, D), CONV_WIDTH ** -0.5),
        'conv_dw_b': nrm((N_CONV_LAYERS, D), 0.01),
        'conv_norm': 1.0 + nrm((N_CONV_LAYERS, D), 0.02),
        'conv_w2': nrm((N_CONV_LAYERS, D, D), D ** -0.5),
        'ret_w_in': nrm((N_RET_LAYERS, D, ret_proj), D ** -0.5),
        'ret_decay_f': dec_logit[None] + nrm((N_RET_LAYERS, RET_HEADS), 0.1),
        'ret_decay_b': dec_logit[None] + nrm((N_RET_LAYERS, RET_HEADS), 0.1),
        'ret_w_out': nrm((N_RET_LAYERS, RET_HEADS * RET_V_DIM, D), (RET_HEADS * RET_V_DIM) ** -0.5),
        'att_w_qkv': nrm((N_ATT_LAYERS, D, att_proj), D ** -0.5),
        'att_q_norm': 1.0 + nrm((N_ATT_LAYERS, ATT_HEAD_DIM), 0.02),
        'att_k_norm': 1.0 + nrm((N_ATT_LAYERS, ATT_HEAD_DIM), 0.02),
        'att_sink': nrm((N_ATT_LAYERS, ATT_Q_HEADS), 0.5),
        'att_w_o': nrm((N_ATT_LAYERS, ATT_Q_HEADS * ATT_HEAD_DIM, D), (ATT_Q_HEADS * ATT_HEAD_DIM) ** -0.5),
        'ffn_w_gu': nrm((DEPTH, D, 2 * FFN_HIDDEN), D ** -0.5),
        'ffn_w_down': nrm((DEPTH, FFN_HIDDEN, D), FFN_HIDDEN ** -0.5),
    }


def reference(x, c, ctx, c_ctx, ada_w, ada_b, norm_mix, norm_ffn,
              conv_w1, conv_b1, conv_dw, conv_dw_b, conv_norm, conv_w2,
              ret_w_in, ret_decay_f, ret_decay_b, ret_w_out,
              att_w_qkv, att_q_norm, att_k_norm, att_sink, att_w_o,
              ffn_w_gu, ffn_w_down):
    rows, cols = grid_positions(x.shape[1])
    h_ctx = ctx
    cond_ctx = c_ctx[None, :]
    for i in range(DEPTH):
        kind, j, last = i % N_MIXERS, i // N_MIXERS, i == DEPTH - 1
        sh_m, sc_m, g_m, sh_f, sc_f, g_f = adaln(c, ada_w[i], ada_b[i])
        hx = modulate(x, norm_mix[i], sh_m, sc_m)
        if (not last) or kind != 0:
            csh_m, csc_m, cg_m, csh_f, csc_f, cg_f = adaln(cond_ctx, ada_w[i], ada_b[i])
            hc = modulate(h_ctx, norm_mix[i], csh_m, csc_m)
        if kind == 0:
            conv_p = (conv_w1[j], conv_b1[j], conv_dw[j], conv_dw_b[j], conv_norm[j], conv_w2[j])
            ox = conv_module(hx, *conv_p)
            oc = None if last else conv_module(hc, *conv_p)
        elif kind == 1:
            oc, ox = retention_mixer(hc, hx, ret_w_in[j], ret_decay_f[j], ret_decay_b[j], ret_w_out[j],
                                     rows, cols, not last)
        else:
            oc, ox = attention_mixer(hc, hx, att_w_qkv[j], att_q_norm[j], att_k_norm[j], att_sink[j],
                                     att_w_o[j], rows, cols, not last)
        x = x + g_m * ox
        x = x + g_f * swiglu_ffn(modulate(x, norm_ffn[i], sh_f, sc_f), ffn_w_gu[i], ffn_w_down[i])
        if not last:
            h_ctx = h_ctx + cg_m * oc
            h_ctx = h_ctx + cg_f * swiglu_ffn(modulate(h_ctx, norm_ffn[i], csh_f, csc_f), ffn_w_gu[i], ffn_w_down[i])
    return x
```

```cpp
#include <hip/hip_runtime.h>
#include <hip/hip_cooperative_groups.h>
#include <cstdio>
#include <cstdint>
namespace cg = cooperative_groups;
namespace pg8 {
#define PG8_LAS __attribute__((address_space(3)))
typedef unsigned short bf16_t;
typedef short bf16x8 __attribute__((ext_vector_type(8)));
typedef float f32x4 __attribute__((ext_vector_type(4)));
typedef unsigned u32x4 __attribute__((ext_vector_type(4)));
constexpr int BM = 256, BK = 64, HALF = 128, HTB = HALF * BK * 2  , STAGE_BYTES = 8 * HTB, NXCD = 8, WGM = 8;

__host__ __device__ __forceinline__ int lds_byte(int r, int c) { const int st = (r >> 4) * 2 + (c >> 5), rr = r & 15, cc = c & 31, ob = rr * 64 + cc * 2; return st * 1024 + (ob ^ (((ob >> 9) & 1) << 5)); }
__host__ __device__ __forceinline__ void stage_rc(int b, int& R, int& C) { const int st = b / 1024, sb = b % 1024, swz = sb ^ (((sb >> 9) & 1) << 5); R = (st >> 1) * 16 + swz / 64; C = (st & 1) * 32 + (swz % 64) / 2; }
__host__ __device__ __forceinline__ int perm32(int rho) { const int n = rho >> 4, i = rho & 15; return 8 * (i >> 2) + 4 * n + (i & 3); }

struct Unit { int pm, pn, kt0, ntu; };
struct Gemm { const bf16_t* A; const bf16_t* Bt; int M, N, K; };

struct StaticOrder {
    int nM, nN, nwg, G, c, ntK, nsplit;
    __host__ __device__ void init(int M, int N, int K, int G_, int c_, int split) { nM = M / BM; nN = N / BM; G = G_; c = c_; ntK = K / BK; nsplit = 0; if (split) { nM -= 1; nsplit = ntK / 2; } nwg = nM * nN; }
    __host__ __device__ __forceinline__ bool next(int i, Unit& u) const {
        const long L = (long)i * G + c;
        int pm, pn, kt0, ntu; bool ok;
        if (L >= nwg) { const int idx = (int)(L - nwg); ok = idx < nN * nsplit; pn = idx % nN; pm = nM; kt0 = 2 * (idx / nN); ntu = 2; }
        else {
            int wgid = (int)L; { const int q = nwg / NXCD, r = nwg % NXCD, xcd = wgid % NXCD, off = wgid / NXCD; wgid = (xcd < r ? xcd * (q + 1) : r * (q + 1) + (xcd - r) * q) + off; }
            const int nig = WGM * nN, gid = wgid / nig, fm = gid * WGM, gsz = (nM - fm) < WGM ? (nM - fm) : WGM;
            pm = fm + ((wgid % nig) % gsz); pn = (wgid % nig) / gsz; kt0 = 0; ntu = ntK; ok = true;
        }
        u.pm = pm; u.pn = pn; u.kt0 = kt0; u.ntu = ntu; return ok;
    }
    __device__ __forceinline__ void a_ready(const Unit&) const {}
    __device__ __forceinline__ void done(const Unit&) const {}
};

__device__ __forceinline__ unsigned cvt_pk_bf16(float lo, float hi) { unsigned r; asm volatile("v_cvt_pk_bf16_f32 %0, %1, %2" : "=v"(r) : "v"(lo), "v"(hi)); return r; }
template <class Epi, class Sched, bool ALIGN_EPI = false, bool SP2 = false>
__device__ __forceinline__ void gemm_phase(PG8_LAS unsigned char* lds, const Gemm g, const Sched& S, const Epi& E) {
    int tid_o = threadIdx.x; asm volatile("" : "+v"(tid_o));
    const int tid = tid_o, wid = __builtin_amdgcn_readfirstlane(tid >> 6), lane = tid & 63, wr = wid >> 2, wc = wid & 3, fr = lane & 15, fq = lane >> 4;
    const int K = g.K, nt = K / BK;
    unsigned voffA[2], voffB[2];
#pragma unroll
    for (int i = 0; i < 2; ++i) { int R, C; stage_rc(tid * 16 + i * 8192, R, C); const int Rb = Epi::PERM ? ((R & ~31) + perm32(R & 31)) : R;
        voffA[i] = (unsigned)(R * K + C) * 2u; voffB[i] = (unsigned)(Rb * K + C) * 2u; }
    const size_t kstep = (size_t)(BK * 2);
    const size_t hstep = (size_t)HALF * K * 2;
    const size_t tstep = 2 * hstep;
    const unsigned ldsw = (unsigned)wid * 1024u;
    const int aoff = lds_byte(wr * 64 + fr, fq * 8), boff = lds_byte(wc * 32 + fr, fq * 8);
#define PG8_SA(b, h) (((b) * 2 + (h)) * HTB)
#define PG8_SB(b, h) ((4 + (b) * 2 + (h)) * HTB)
#define PG8_STAGE(bufoff, gbase, voff) do { _Pragma("unroll") for (int _i = 0; _i < 2; ++_i) \
        __builtin_amdgcn_global_load_lds((const unsigned*)((const char*)(gbase) + (voff)[_i]), (PG8_LAS unsigned*)(lds + (bufoff) + ldsw + _i * 8192), 16, 0, 0); } while (0)
#define PG8_LDA(dst, b, h) do { _Pragma("unroll") for (int m = 0; m < 4; ++m) _Pragma("unroll") for (int k = 0; k < 2; ++k) dst[m][k] = *(const PG8_LAS bf16x8*)(lds + PG8_SA(b, h) + aoff + m * 2048 + k * 1024); } while (0)
#define PG8_LDB(dst, b, h) do { _Pragma("unroll") for (int n = 0; n < 2; ++n) _Pragma("unroll") for (int k = 0; k < 2; ++k) dst[n][k] = *(const PG8_LAS bf16x8*)(lds + PG8_SB(b, h) + boff + n * 2048 + k * 1024); } while (0)
#define PG8_MMA(ai, bj, At, Bt) do { __builtin_amdgcn_s_setprio(1); _Pragma("unroll") for (int m = 0; m < 4; ++m) _Pragma("unroll") for (int n = 0; n < 2; ++n) _Pragma("unroll") for (int k = 0; k < 2; ++k) \
        acc[ai][bj][m][n] = __builtin_amdgcn_mfma_f32_16x16x32_bf16(Bt[n][k], At[m][k], acc[ai][bj][m][n], 0, 0, 0); __builtin_amdgcn_s_setprio(0); } while (0)
#define PG8_WAIT_V(n) asm volatile("s_waitcnt vmcnt(" #n ")" ::: "memory")
#define PG8_WAIT_L(n) asm volatile("s_waitcnt lgkmcnt(" #n ")" ::: "memory")
#define PG8_BAR __builtin_amdgcn_s_barrier()
#define PG8_SCHED __builtin_amdgcn_sched_barrier(0)
    Unit cur, nxt; int ui = 0;
    if (!S.next(0, cur)) return;
    f32x4 acc[2][2][4][2];
#pragma unroll
    for (int a = 0; a < 2; ++a)
#pragma unroll
        for (int b = 0; b < 2; ++b)
#pragma unroll
            for (int m = 0; m < 4; ++m)
#pragma unroll
                for (int n = 0; n < 2; ++n) acc[a][b][m][n] = (f32x4){0.f, 0.f, 0.f, 0.f};
    bf16x8 At[4][2], B0[2][2], B1[2][2];
    const char* cA = (const char*)g.A + (size_t)cur.pm * tstep + (size_t)cur.kt0 * kstep; const char* cB = (const char*)g.Bt + (size_t)cur.pn * tstep + (size_t)cur.kt0 * kstep;
    S.a_ready(cur);
    if constexpr (SP2) {
        PG8_STAGE(PG8_SB(0, 0), cB, voffB); PG8_STAGE(PG8_SB(0, 1), cB + hstep, voffB); PG8_STAGE(PG8_SA(0, 0), cA, voffA); PG8_STAGE(PG8_SA(0, 1), cA + hstep, voffA);
        if (wr == 1) PG8_BAR;
        PG8_WAIT_V(2); PG8_BAR;
        PG8_STAGE(PG8_SB(1, 0), cB + kstep, voffB); PG8_STAGE(PG8_SA(1, 0), cA + kstep, voffA); PG8_STAGE(PG8_SB(1, 1), cB + hstep + kstep, voffB);
        PG8_WAIT_V(6); PG8_BAR;
    } else {
        PG8_STAGE(PG8_SB(0, 0), cB, voffB); PG8_STAGE(PG8_SA(0, 0), cA, voffA); PG8_STAGE(PG8_SB(0, 1), cB + hstep, voffB); PG8_STAGE(PG8_SA(0, 1), cA + hstep, voffA);
        if (wr == 1) PG8_BAR;
        PG8_WAIT_V(4); PG8_BAR;
        PG8_STAGE(PG8_SB(1, 0), cB + kstep, voffB); PG8_STAGE(PG8_SA(1, 0), cA + kstep, voffA); PG8_STAGE(PG8_SB(1, 1), cB + hstep + kstep, voffB);
        PG8_WAIT_V(6); PG8_BAR;
    }
    for (;;) {
        const bool has_next = S.next(ui + 1, nxt);
        const char* nA = has_next ? (const char*)g.A + (size_t)nxt.pm * tstep + (size_t)nxt.kt0 * kstep : cA; const char* nB = has_next ? (const char*)g.Bt + (size_t)nxt.pn * tstep + (size_t)nxt.kt0 * kstep : cB;
        const int ntc = cur.ntu;
        for (int t = 0; t < ntc; t += 2) {
            const bool last = (t == ntc - 2);
            const char* a1 = cA + (size_t)(t + 1) * kstep;
            const char* a2 = last ? nA : cA + (size_t)(t + 2) * kstep; const char* b2 = last ? nB : cB + (size_t)(t + 2) * kstep;
            const char* a3 = a2 + kstep; const char* b3 = b2 + kstep;
            if (last && has_next) S.a_ready(nxt);
            if constexpr (SP2) {
            PG8_LDB(B0, 0, 0); PG8_LDB(B1, 0, 1); PG8_SCHED; PG8_LDA(At, 0, 0); PG8_STAGE(PG8_SA(1, 1), a1 + hstep, voffA);
            PG8_WAIT_V(8); PG8_WAIT_L(0); PG8_BAR; PG8_MMA(0, 0, At, B0); PG8_MMA(0, 1, At, B1); PG8_BAR; PG8_SCHED;
            PG8_LDA(At, 0, 1); PG8_STAGE(PG8_SB(0, 0), b2, voffB); PG8_STAGE(PG8_SB(0, 1), b2 + hstep, voffB); PG8_STAGE(PG8_SA(0, 0), a2, voffA);
            PG8_WAIT_V(8); PG8_WAIT_L(0); PG8_BAR; PG8_MMA(1, 0, At, B0); PG8_MMA(1, 1, At, B1); PG8_BAR; PG8_SCHED;
            PG8_LDB(B0, 1, 0); PG8_LDB(B1, 1, 1); PG8_SCHED; PG8_LDA(At, 1, 0); PG8_STAGE(PG8_SA(0, 1), a2 + hstep, voffA);
            PG8_WAIT_V(8); PG8_WAIT_L(0); PG8_BAR; PG8_MMA(0, 0, At, B0); PG8_MMA(0, 1, At, B1); PG8_BAR; PG8_SCHED;
            PG8_LDA(At, 1, 1); PG8_STAGE(PG8_SB(1, 0), b3, voffB); PG8_STAGE(PG8_SB(1, 1), b3 + hstep, voffB); PG8_STAGE(PG8_SA(1, 0), a3, voffA);
            PG8_WAIT_V(8); PG8_WAIT_L(0); PG8_BAR; PG8_MMA(1, 0, At, B0); PG8_MMA(1, 1, At, B1); PG8_BAR; PG8_SCHED;
            } else {
            PG8_LDB(B0, 0, 0); PG8_SCHED; PG8_LDA(At, 0, 0); PG8_STAGE(PG8_SA(1, 1), a1 + hstep, voffA);
            PG8_WAIT_L(8); PG8_BAR; PG8_WAIT_L(0); PG8_MMA(0, 0, At, B0); PG8_BAR; PG8_SCHED;
            PG8_LDB(B1, 0, 1); PG8_STAGE(PG8_SB(0, 0), b2, voffB);
            PG8_BAR; PG8_WAIT_L(0); PG8_MMA(0, 1, At, B1); PG8_BAR;
            PG8_LDA(At, 0, 1); PG8_STAGE(PG8_SA(0, 0), a2, voffA);
            PG8_BAR; PG8_WAIT_L(0); PG8_MMA(1, 0, At, B0); PG8_BAR; PG8_SCHED;
            PG8_STAGE(PG8_SB(0, 1), b2 + hstep, voffB);
            PG8_WAIT_V(6); PG8_BAR; PG8_MMA(1, 1, At, B1); PG8_BAR;
            PG8_LDB(B0, 1, 0); PG8_SCHED; PG8_LDA(At, 1, 0); PG8_STAGE(PG8_SA(0, 1), a2 + hstep, voffA);
            PG8_WAIT_L(8); PG8_BAR; PG8_WAIT_L(0); PG8_MMA(0, 0, At, B0); PG8_BAR; PG8_SCHED;
            PG8_LDB(B1, 1, 1); PG8_STAGE(PG8_SB(1, 0), b3, voffB);
            PG8_BAR; PG8_WAIT_L(0); PG8_MMA(0, 1, At, B1); PG8_BAR;
            PG8_LDA(At, 1, 1); PG8_STAGE(PG8_SA(1, 0), a3, voffA);
            PG8_BAR; PG8_WAIT_L(0); PG8_MMA(1, 0, At, B0); PG8_BAR; PG8_SCHED;
            PG8_STAGE(PG8_SB(1, 1), b3 + hstep, voffB);
            PG8_WAIT_V(6); PG8_BAR; PG8_MMA(1, 1, At, B1); PG8_BAR;
            }
        }
        if constexpr (ALIGN_EPI) { if (wr == 0) PG8_BAR; }
        if constexpr (!Epi::AFTER_DRAIN) { E(acc, cur, wr, wc, fr, fq); S.done(cur); }
        if (!has_next) break;
#pragma unroll
        for (int a = 0; a < 2; ++a)
#pragma unroll
            for (int b = 0; b < 2; ++b)
#pragma unroll
                for (int m = 0; m < 4; ++m)
#pragma unroll
                    for (int n = 0; n < 2; ++n) acc[a][b][m][n] = (f32x4){0.f, 0.f, 0.f, 0.f};
        cur = nxt; cA = nA; cB = nB; ++ui;
        if constexpr (ALIGN_EPI) { if (wr == 1) PG8_BAR; }
    }
    PG8_WAIT_V(0);
    if constexpr (!ALIGN_EPI) { if (wr == 0) PG8_BAR; }
    PG8_BAR;
    if constexpr (Epi::AFTER_DRAIN) { E.fused(acc, cur, wr, wc, fr, fq, lds, wid, lane); S.done(cur); }
#undef PG8_SA
#undef PG8_SB
#undef PG8_STAGE
#undef PG8_LDA
#undef PG8_LDB
#undef PG8_MMA
#undef PG8_WAIT_V
#undef PG8_WAIT_L
#undef PG8_BAR
#undef PG8_SCHED
}
}

#define LAS __attribute__((address_space(3)))
typedef unsigned short bf16;
typedef short bf16x8 __attribute__((ext_vector_type(8)));
typedef float f32x4 __attribute__((ext_vector_type(4)));
typedef float f32x16 __attribute__((ext_vector_type(16)));
typedef unsigned u32x4 __attribute__((ext_vector_type(4)));
typedef unsigned u32x2 __attribute__((ext_vector_type(2)));
typedef float f32x2 __attribute__((ext_vector_type(2)));

constexpr int T_ = 16384, L_ = 256, MT_ = 16640, D_ = 1024, F_ = 2816;
constexpr int NTHREADS = 512, NWAVES = 8;
constexpr int LDS_BYTES = 131072 + 512;
constexpr int VCU_OFF = 131072 + 496;
constexpr int PARAM_OFF = 131072 + 256;
constexpr size_t MiB = 1u << 20;
constexpr size_t WS_MODS = 0, WS_XC = 1 * MiB, WS_WM = 2 * MiB, WS_WF = 18 * MiB, WS_HX = 35 * MiB, WS_R = 68 * MiB;
constexpr size_t WS_Y1 = WS_R, WS_Y2 = WS_R + 33 * MiB;
constexpr size_t WS_H = WS_R;
constexpr size_t WS_RQ = WS_R, WS_RK = WS_R + 33 * MiB, WS_RG = WS_R + 66 * MiB, WS_RKT = WS_R + 131 * MiB, WS_RVT = WS_R + 164 * MiB,
                 WS_ROI = WS_R + 229 * MiB, WS_ROIC = WS_R + 293 * MiB, WS_END = WS_R + 300 * MiB;
constexpr size_t WS_AQ = WS_R, WS_AK = WS_R + 33 * MiB, WS_AVT = WS_R + 42 * MiB, WS_AO = WS_R + 66 * MiB;
static_assert(WS_END <= 384 * MiB, "ws");
constexpr size_t WS_BAR = 512 * 1024;

struct Params { const float* in[25]; float* out; unsigned char* ws; };
__device__ __forceinline__ int rfl_i(int v) { return __builtin_amdgcn_readfirstlane(v); }
template <class P> __device__ __forceinline__ P rfl_p(P v) { const unsigned long long x = (unsigned long long)v; const unsigned lo = __builtin_amdgcn_readfirstlane((unsigned)x), hi = __builtin_amdgcn_readfirstlane((unsigned)(x >> 32)); return (P)(((unsigned long long)hi << 32) | lo); }
template <class T> __device__ __forceinline__ T* as_global(T* p) { return (T*)(__attribute__((address_space(1))) T*)(unsigned long long)p; }
struct LP {
    const LAS unsigned long long* q;
    __device__ __forceinline__ const float* in(int i) const { return as_global((const float*)rfl_p(q[i])); }
    __device__ __forceinline__ float* out() const { return as_global((float*)rfl_p(q[25])); }
    __device__ __forceinline__ unsigned char* ws() const { return as_global((unsigned char*)rfl_p(q[26])); }
};

__device__ __forceinline__ int otid() { int t = threadIdx.x; asm volatile("" : "+v"(t)); return t; }
__device__ __forceinline__ size_t tr_off(int row, int tok, int NR) { return ((size_t)(tok >> 7) * NR + row) * 128 + (tok & 127); }
__device__ __forceinline__ size_t kt_off(int row, int tok) { const int h = row >> 8, d = row & 255, t = tok & 127;
    return ((((size_t)(tok >> 7) * 4 + h) * 8 + (d >> 5)) * 8 + (t >> 4)) * 512 + ((((t >> 3) & 1) * 32 + (d & 31)) * 8) + (t & 7); }
__device__ __forceinline__ size_t q_off(int row, int h, int sd) { const int t = row & 127;
    return ((((size_t)(row >> 7) * 4 + h) * 8 + (t >> 4)) * 8 + (sd >> 5)) * 512 + ((((sd >> 3) & 3) * 16 + (t & 15)) * 8) + (sd & 7); }
__device__ __forceinline__ float bf2f(unsigned short u) { return __uint_as_float(((unsigned)u) << 16); }
typedef __bf16 bf16x2_t __attribute__((ext_vector_type(2)));
__device__ __forceinline__ unsigned pk2(float lo, float hi) { const f32x2 v = {lo, hi}; const bf16x2_t b = __builtin_convertvector(v, bf16x2_t); return __builtin_bit_cast(unsigned, b); }
__device__ __forceinline__ float silu_f(float x) { return x / (1.0f + __expf(-x)); }
__device__ __forceinline__ float sigmoid_f(float x) { return 1.0f / (1.0f + __expf(-x)); }
__device__ __forceinline__ void st4bf(bf16* p, f32x4 v) { u32x2 w; w.x = pk2(v[0], v[1]); w.y = pk2(v[2], v[3]); *(u32x2*)p = w; }
__device__ __forceinline__ float wave_sum(float v) {
#pragma unroll
    for (int o = 1; o < 64; o <<= 1) v += __shfl_xor(v, o);
    return v;
}

#ifndef EPI_MASK
#define EPI_MASK 0x7f
#endif
#define EPI_ON(m) ((EPI_MASK >> (m)) & 1)
enum { EM_GLU = 0, EM_SWIGLU = 1, EM_RES = 2, EM_RET = 3, EM_RETT = 4, EM_ATT = 5, EM_PLAIN = 6 };
struct EpiD {
    int mode, ldc, M, N, K, pad;
    const bf16* A; const bf16* Bt;
    bf16* o0; bf16* o1; bf16* o2;
    const float* bias; const float* baseL; const float* baseC; float* outL; float* outC;
    const float* gateL; const float* gateC; const float* gq; const float* gk;
    float* part;
};
constexpr int DESC_OFF = 131072;
struct Epi {
    static constexpr bool PERM = false, AFTER_DRAIN = false;
    const LAS EpiD* d;
    __device__ __forceinline__ void operator()(const f32x4 (&acc)[2][2][4][2], const pg8::Unit& u, int wr_, int wc_, int fr_, int fq_) const {
        const int mode = rfl_i(d->mode);
        using namespace pg8;
        int wr = wr_, wc = wc_, fr = fr_, fq = fq_;
        asm volatile("" : "+v"(fr), "+v"(fq)); asm volatile("" : "+s"(wr), "+s"(wc));
        const int rowb = u.pm * BM + wr * 64 + fr;
        const int colb = u.pn * BM + wc * 32 + 4 * fq;
        if ((EPI_ON(EM_GLU) && mode == EM_GLU) || (EPI_ON(EM_SWIGLU) && mode == EM_SWIGLU)) {
            const int ch = u.pn * 128 + wc * 32 + 4 * fq;
            bf16* const o0 = as_global(d->o0); const float* const bias = as_global(d->bias); const int ldc = d->ldc;
            f32x4 ba[2], bg[2];
#pragma unroll
            for (int n = 0; n < 2; ++n) {
                if (mode == EM_GLU) { ba[n] = *(const f32x4*)(bias + ch + 16 * n); bg[n] = *(const f32x4*)(bias + 1024 + ch + 16 * n); }
                else { ba[n] = (f32x4){0.f, 0.f, 0.f, 0.f}; bg[n] = ba[n]; }
            }
#pragma unroll
            for (int ai = 0; ai < 2; ++ai)
#pragma unroll
                for (int m = 0; m < 4; ++m) {
                    bf16* rp = o0 + (size_t)(rowb + ai * HALF + m * 16) * ldc + ch;
#pragma unroll
                    for (int n = 0; n < 2; ++n) {
                        const f32x4 a = acc[ai][0][m][n] + ba[n], g = acc[ai][1][m][n] + bg[n];
                        f32x4 v;
                        if (mode == EM_GLU) { v[0] = a[0] * sigmoid_f(g[0]); v[1] = a[1] * sigmoid_f(g[1]); v[2] = a[2] * sigmoid_f(g[2]); v[3] = a[3] * sigmoid_f(g[3]); }
                        else { v[0] = silu_f(a[0]) * g[0]; v[1] = silu_f(a[1]) * g[1]; v[2] = silu_f(a[2]) * g[2]; v[3] = silu_f(a[3]) * g[3]; }
                        st4bf(rp + 16 * n, v);
                    }
                }
        } else if (EPI_ON(EM_RES) && mode == EM_RES) {
            const bool isc = (u.pm >= T_ / BM);
            const float* gt = isc ? as_global(d->gateC) : as_global(d->gateL);
            f32x4 gv[2][2];
#pragma unroll
            for (int bj = 0; bj < 2; ++bj)
#pragma unroll
                for (int n = 0; n < 2; ++n) gv[bj][n] = *(const f32x4*)(gt + colb + bj * HALF + 16 * n);
            const float* bs = isc ? as_global(d->baseC) : as_global(d->baseL); float* ot = isc ? as_global(d->outC) : as_global(d->outL);
            const int rsub = isc ? T_ : 0;
#pragma unroll
            for (int ai = 0; ai < 2; ++ai)
#pragma unroll
                for (int m = 0; m < 4; ++m) {
                    const size_t off = (size_t)(rowb + ai * HALF + m * 16 - rsub) * D_ + colb;
#pragma unroll
                    for (int bj = 0; bj < 2; ++bj)
#pragma unroll
                        for (int n = 0; n < 2; ++n) {
                            if (isc) {
                                *(f32x4*)(as_global(d->part) + (size_t)(u.kt0 >> 1) * (L_ * D_) + off + bj * HALF + 16 * n) = gv[bj][n] * acc[ai][bj][m][n];
                            } else {
                                const f32x4 b = *(const f32x4*)(bs + off + bj * HALF + 16 * n);
                                *(f32x4*)(ot + off + bj * HALF + 16 * n) = b + gv[bj][n] * acc[ai][bj][m][n];
                            }
                        }
                }
        } else if (EPI_ON(EM_RET) && mode == EM_RET) {
            bf16* const o0 = as_global(d->o0); bf16* const o1 = as_global(d->o1); bf16* const o2 = as_global(d->o2);
            if (u.pn >= 4 && u.pn < 12) {
                const int cg0 = (u.pn - 4) * BM + wc * 32 + 4 * fq;
#pragma unroll
                for (int ai = 0; ai < 2; ++ai)
#pragma unroll
                    for (int m = 0; m < 4; ++m) {
                        bf16* rp = o1 + (size_t)(rowb + ai * HALF + m * 16) * 2048 + cg0;
#pragma unroll
                        for (int bj = 0; bj < 2; ++bj)
#pragma unroll
                            for (int n = 0; n < 2; ++n) { const f32x4 a = acc[ai][bj][m][n]; f32x4 v; v[0] = silu_f(a[0]); v[1] = silu_f(a[1]); v[2] = silu_f(a[2]); v[3] = silu_f(a[3]); st4bf(rp + bj * HALF + 16 * n, v); }
                    }
            } else {
                const bool isk = u.pn >= 12; const int h = u.pn & 3; bf16* ob = isk ? o2 : o0; const float sc = isk ? 0.0625f : 1.0f;
                float inv[2][4];
#pragma unroll
                for (int n = 0; n < 2; ++n)
#pragma unroll
                    for (int e = 0; e < 4; ++e) { const int i = 32 * (wc & 1) + 16 * n + 4 * fq + e; inv[n][e] = exp2f(-(float)i * (13.287712379549449f / 64.0f)); }
                const int j0 = wc * 32 + 4 * fq;
#pragma unroll
                for (int ai = 0; ai < 2; ++ai)
#pragma unroll
                    for (int m = 0; m < 4; ++m) {
                        const int row = rowb + ai * HALF + m * 16;
                        const bool lat = row < T_;
                        const float pos = (float)((wc < 2) ? (row >> 6) : (row & 63));
                        bf16* rp = ob + (size_t)row * 1024 + 256 * h + j0;
#pragma unroll
                        for (int n = 0; n < 2; ++n) {
                            const f32x4 x1 = acc[ai][0][m][n], x2 = acc[ai][1][m][n]; f32x4 r1, r2;
#pragma unroll
                            for (int e = 0; e < 4; ++e) {
                                const float ang = pos * inv[n][e]; float c = __cosf(ang), s = __sinf(ang);
                                if (!lat) { c = 1.f; s = 0.f; }
                                r1[e] = (x1[e] * c - x2[e] * s) * sc; r2[e] = (x2[e] * c + x1[e] * s) * sc;
                            }
                            if (isk) { st4bf(rp + 16 * n, r1); st4bf(rp + 128 + 16 * n, r2); }
                            else { st4bf(ob + q_off(row, h, j0 + 16 * n), r1); st4bf(ob + q_off(row, h, j0 + 16 * n + 128), r2); }
                        }
                    }
            }
        } else if (EPI_ON(EM_RETT) && mode == EM_RETT) {
            bf16* const o0 = as_global(d->o0); bf16* const o1 = as_global(d->o1);
            if (u.pm >= 4) {
#pragma unroll
                for (int ai = 0; ai < 2; ++ai)
#pragma unroll
                    for (int m = 0; m < 4; ++m) {
                        const int vrow = rowb - 4 * BM + ai * HALF + m * 16;
#pragma unroll
                        for (int bj = 0; bj < 2; ++bj)
#pragma unroll
                            for (int n = 0; n < 2; ++n) st4bf(o1 + tr_off(vrow, colb + bj * HALF + 16 * n, 2048), acc[ai][bj][m][n]);
                    }
            } else {
                float inv[4];
#pragma unroll
                for (int m = 0; m < 4; ++m) { const int i = 16 * m + fr; inv[m] = exp2f(-(float)i * (13.287712379549449f / 64.0f)); }
#pragma unroll
                for (int bj = 0; bj < 2; ++bj)
#pragma unroll
                    for (int n = 0; n < 2; ++n) {
                        const int tok0 = colb + bj * HALF + 16 * n;
                        const bool lat = tok0 < T_;
#pragma unroll
                        for (int m = 0; m < 4; ++m) {
                            const f32x4 x1 = acc[0][bj][m][n], x2 = acc[1][bj][m][n]; f32x4 r1, r2;
#pragma unroll
                            for (int e = 0; e < 4; ++e) {
                                const int tok = tok0 + e;
                                const float pos = (float)((wr == 0) ? (tok >> 6) : (tok & 63));
                                const float ang = pos * inv[m]; float c = __cosf(ang), s = __sinf(ang);
                                if (!lat) { c = 1.f; s = 0.f; }
                                r1[e] = (x1[e] * c - x2[e] * s) * 0.0625f; r2[e] = (x2[e] * c + x1[e] * s) * 0.0625f;
                            }
                            const int row = u.pm * BM + wr * 64 + m * 16 + fr;
                            st4bf(o0 + kt_off(row, tok0), r1); st4bf(o0 + kt_off(row + 128, tok0), r2);
                        }
                    }
            }
        } else if (EPI_ON(EM_ATT) && mode == EM_ATT) {
            bf16* const o0 = as_global(d->o0); bf16* const o1 = as_global(d->o1);
            const bool isk = u.pn >= 4; const float* gn = isk ? as_global(d->gk) : as_global(d->gq);
            f32x4 gv[2][2];
#pragma unroll
            for (int bj = 0; bj < 2; ++bj)
#pragma unroll
                for (int n = 0; n < 2; ++n) gv[bj][n] = *(const f32x4*)(gn + 32 * n + 16 * bj + 4 * fq);
            float inv[4];
#pragma unroll
            for (int e = 0; e < 4; ++e) { const int i = 4 * fq + e; inv[e] = exp2f(-(float)i * (13.287712379549449f / 16.0f)); }
            const float sc = isk ? 1.0f : 0.125f;
            bf16* ob = isk ? o1 : o0; const int ld = isk ? 256 : 1024;
            const int cb = (isk ? 0 : u.pn * BM) + 64 * wc + 4 * fq;
#pragma unroll
            for (int ai = 0; ai < 2; ++ai)
#pragma unroll
                for (int m = 0; m < 4; ++m) {
                    const int row = rowb + ai * HALF + m * 16;
                    const bool lat = row < T_;
                    float ss = 0.f;
#pragma unroll
                    for (int bj = 0; bj < 2; ++bj)
#pragma unroll
                        for (int n = 0; n < 2; ++n) { const f32x4 a = acc[ai][bj][m][n]; ss += (a[0] * a[0] + a[1] * a[1]) + (a[2] * a[2] + a[3] * a[3]); }
                    ss += __shfl_xor(ss, 16); ss += __shfl_xor(ss, 32);
                    const float rstd = rsqrtf(ss * (1.0f / 64.0f) + 1e-6f);
                    bf16* rp = ob + (size_t)row * ld + cb;
#pragma unroll
                    for (int n = 0; n < 2; ++n) {
                        const float pos = (float)((n == 0) ? (row >> 6) : (row & 63));
                        const f32x4 y1 = acc[ai][0][m][n] * rstd * gv[0][n], y2 = acc[ai][1][m][n] * rstd * gv[1][n]; f32x4 r1, r2;
#pragma unroll
                        for (int e = 0; e < 4; ++e) {
                            const float ang = pos * inv[e]; float c = __cosf(ang), s = __sinf(ang);
                            if (!lat) { c = 1.f; s = 0.f; }
                            r1[e] = (y1[e] * c - y2[e] * s) * sc; r2[e] = (y2[e] * c + y1[e] * s) * sc;
                        }
                        st4bf(rp + 16 * n, r1); st4bf(rp + 32 + 16 * n, r2);
                    }
                }
        } else if (EPI_ON(EM_PLAIN)) {
            bf16* const o0 = as_global(d->o0); const int ldc = d->ldc;
#pragma unroll
            for (int ai = 0; ai < 2; ++ai)
#pragma unroll
                for (int m = 0; m < 4; ++m) {
                    const int vrow = rowb + ai * HALF + m * 16;
#pragma unroll
                    for (int bj = 0; bj < 2; ++bj)
#pragma unroll
                        for (int n = 0; n < 2; ++n) st4bf(o0 + tr_off(vrow, colb + bj * HALF + 16 * n, ldc), acc[ai][bj][m][n]);
                }
        }
    }
};

__device__ __forceinline__ void run_gemm(LAS unsigned char* lds) {
    const LAS EpiD* d = (const LAS EpiD*)(lds + DESC_OFF);
    const int M = rfl_i(d->M), N = rfl_i(d->N), K = rfl_i(d->K);
    pg8::Gemm g{as_global(rfl_p(d->A)), as_global(rfl_p(d->Bt)), M, N, K}; pg8::StaticOrder S; const int md = rfl_i(d->mode); const int G = (int)gridDim.x;
    const int vcu = rfl_i(*(volatile LAS int*)(lds + VCU_OFF));
    const int cb = (md == EM_RETT || md == EM_PLAIN) ? (int)(((unsigned)vcu + (unsigned)G / 2u) % (unsigned)G) : vcu;
    S.init(M, N, K, G, cb, (md == EM_RES && M == MT_) ? 1 : 0);
    Epi E; E.d = d;
#ifndef NO_GEMM
    pg8::gemm_phase<Epi, pg8::StaticOrder, true, true>(lds, g, S, E);
#endif
    __syncthreads();
}

__device__ __forceinline__ int dest_row(int kind, int n, int N) {
    if (kind == 1) { const int half = N >> 1; if (n < half) return ((n >> 7) << 8) + (n & 127); const int q = n - half; return ((q >> 7) << 8) + 128 + (q & 127); }
    if (kind == 2) {
        if (n < 2048) { const int isk = n >> 10, hn = n & 1023, h = hn >> 8, d = hn & 255, bj = (d >> 6) & 1, j = (d & 63) + ((d >> 7) << 6); return (isk ? 3072 : 0) + 256 * h + 128 * bj + j; }
        if (n < 4096) return 4096 + (n - 2048);
        return 1024 + (n - 4096);
    }
    if (kind == 3) {
        if (n < 1280) { const int isk = n >= 1024; const int hn = isk ? n - 1024 : n; const int head = hn >> 6, d = hn & 63, bj = (d >> 4) & 1, nn = d >> 5, jj = d & 15;
            const int pn = isk ? 4 : (head >> 2), wc = head & 3; return 256 * pn + 128 * bj + 32 * wc + 16 * nn + jj; }
        return n;
    }
    return n;
}
__device__ __forceinline__ void convert_matrix(const float* W, int K, int N, bf16* WT, int kind, LAS float* scr, int gw, int NGW, int lane) {
    const int nblk = N / 32, nitems = (K / 64) * nblk;
    for (int item = gw; item < nitems; item += NGW) {
        const int kb = item / nblk, nb = item % nblk, k0 = 64 * kb, n0 = 32 * nb;
        float wreg[32];
#pragma unroll
        for (int i = 0; i < 32; ++i) { const int kk = 2 * i + (lane >> 5); wreg[i] = W[(size_t)(k0 + kk) * N + n0 + (lane & 31)]; }
        __builtin_amdgcn_sched_barrier(0);
#pragma unroll
        for (int i = 0; i < 32; ++i) { const int kk = 2 * i + (lane >> 5); scr[kk * 33 + (lane & 31)] = wreg[i]; }
        asm volatile("s_waitcnt lgkmcnt(0)" ::: "memory");
        const int c = lane & 7;
#pragma unroll
        for (int j = 0; j < 4; ++j) { const int n = (lane >> 3) + 8 * j; const LAS float* s = scr + (8 * c) * 33 + n;
            u32x4 o; o.x = pk2(s[0 * 33], s[1 * 33]); o.y = pk2(s[2 * 33], s[3 * 33]); o.z = pk2(s[4 * 33], s[5 * 33]); o.w = pk2(s[6 * 33], s[7 * 33]);
            *(u32x4*)(WT + (size_t)dest_row(kind, n0 + n, N) * K + k0 + 8 * c) = o; }
        asm volatile("s_waitcnt lgkmcnt(0)" ::: "memory");
    }
}
__device__ __forceinline__ void convert_mixer(const LP& p, int l, LAS unsigned char* lds, int bidx, int nblk) {
    const int tid = otid(), lane = tid & 63, wave = tid >> 6; const int gw = bidx * NWAVES + wave, NGW = nblk * NWAVES;
    LAS float* scr = (LAS float*)(lds + wave * 8704);
    bf16* wm = (bf16*)(p.ws() + WS_WM);
    const int kind = l % 3, j = l / 3;
    if (kind == 0) {
        convert_matrix(p.in(8) + (size_t)j * 1024 * 2048, 1024, 2048, wm, 1, scr, gw, NGW, lane);
        convert_matrix(p.in(13) + (size_t)j * 1024 * 1024, 1024, 1024, wm + 4 * MiB / 2, 0, scr, gw, NGW, lane);
    } else if (kind == 1) {
        convert_matrix(p.in(14) + (size_t)j * 1024 * 6144, 1024, 6144, wm, 2, scr, gw, NGW, lane);
        convert_matrix(p.in(17) + (size_t)j * 2048 * 1024, 2048, 1024, wm + 12 * MiB / 2, 0, scr, gw, NGW, lane);
    } else {
        convert_matrix(p.in(18) + (size_t)j * 1024 * 1536, 1024, 1536, wm, 3, scr, gw, NGW, lane);
        convert_matrix(p.in(22) + (size_t)j * 1024 * 1024, 1024, 1024, wm + 4 * MiB / 2, 0, scr, gw, NGW, lane);
    }
}
__device__ __forceinline__ void convert_ffn(const LP& p, int l, LAS unsigned char* lds, int bidx, int nblk) {
    const int tid = otid(), lane = tid & 63, wave = tid >> 6; const int gw = bidx * NWAVES + wave, NGW = nblk * NWAVES;
    LAS float* scr = (LAS float*)(lds + wave * 8704);
    bf16* wf = (bf16*)(p.ws() + WS_WF);
    convert_matrix(p.in(23) + (size_t)l * 1024 * 5632, 1024, 5632, wf, 1, scr, gw, NGW, lane);
    convert_matrix(p.in(24) + (size_t)l * 2816 * 1024, 2816, 1024, wf + 11 * MiB / 2, 0, scr, gw, NGW, lane);
}

constexpr size_t WS_ADAP = WS_R;
__device__ __forceinline__ void phase_adaln_partial(const LP& p) {
    const int tid = otid();
    float* part = (float*)(p.ws() + WS_ADAP);
    const float* c = p.in(1); const float* cc = p.in(3);
    for (int u = blockIdx.x; u < 256; u += gridDim.x) {
        const int l = u >> 6, k0 = (u & 63) * 16;
        const float* W = p.in(4) + (size_t)l * 1024 * 6144 + (size_t)k0 * 6144;
        f32x4 a0[3], a1[3];
#pragma unroll
        for (int q = 0; q < 3; ++q) { a0[q] = (f32x4){0.f, 0.f, 0.f, 0.f}; a1[q] = a0[q]; }
#pragma unroll
        for (int hb = 0; hb < 2; ++hb) {
            f32x4 wb[8][3]; float s0[8], s1[8];
#pragma unroll
            for (int kk = 0; kk < 8; ++kk) {
#pragma unroll
                for (int q = 0; q < 3; ++q) wb[kk][q] = *(const f32x4*)(W + (size_t)(8 * hb + kk) * 6144 + 4 * tid + 2048 * q);
                s0[kk] = c[k0 + 8 * hb + kk]; s1[kk] = cc[k0 + 8 * hb + kk];
            }
            __builtin_amdgcn_sched_barrier(0);
#pragma unroll
            for (int kk = 0; kk < 8; ++kk) {
                const float t0 = silu_f(s0[kk]), t1 = silu_f(s1[kk]);
#pragma unroll
                for (int q = 0; q < 3; ++q) { a0[q] += wb[kk][q] * t0; a1[q] += wb[kk][q] * t1; }
            }
        }
#pragma unroll
        for (int q = 0; q < 3; ++q) { *(f32x4*)(part + (size_t)(u * 2 + 0) * 6144 + 4 * tid + 2048 * q) = a0[q]; *(f32x4*)(part + (size_t)(u * 2 + 1) * 6144 + 4 * tid + 2048 * q) = a1[q]; }
    }
}
__device__ __forceinline__ void phase_adaln_reduce(const LP& p) {
    const int tid = otid();
    const float* part = (const float*)(p.ws() + WS_ADAP); float* mods = (float*)(p.ws() + WS_MODS);
    for (int i = blockIdx.x * NTHREADS + tid; i < 4 * 2 * 6144 / 4; i += gridDim.x * NTHREADS) {
        const int l = i / (2 * 1536), r = i % (2 * 1536), sidx = r / 1536, c4 = r % 1536;
        f32x4 acc = *(const f32x4*)(p.in(5) + l * 6144 + 4 * c4);
#pragma unroll 8
        for (int kc = 0; kc < 64; ++kc) acc += *(const f32x4*)(part + (size_t)((l * 64 + kc) * 2 + sidx) * 6144 + 4 * c4);
        *(f32x4*)(mods + (size_t)(l * 2 + sidx) * 6144 + 4 * c4) = acc;
    }
}

__device__ __forceinline__ void phase_norm(const LP& p, int l, bool ffn, const float* xl, float* xc, const float* part, int nparts) {
    const int tid = otid(), lane = tid & 63, wave = tid >> 6; const int gw = blockIdx.x * NWAVES + wave, NGW = gridDim.x * NWAVES;
    const float* mods = (const float*)(p.ws() + WS_MODS);
    const float* g = (ffn ? p.in(7) : p.in(6)) + l * 1024;
    bf16* HX = (bf16*)(p.ws() + WS_HX);
    f32x4 gv[4];
#pragma unroll
    for (int j = 0; j < 4; ++j) gv[j] = *(const f32x4*)(g + 4 * lane + 256 * j);
    {
        const float* mb = mods + (size_t)(l * 2) * 6144 + (ffn ? 3072 : 0);
        f32x4 sh[4], sc[4], vn[4];
#pragma unroll
        for (int j = 0; j < 4; ++j) { sh[j] = *(const f32x4*)(mb + 4 * lane + 256 * j); sc[j] = *(const f32x4*)(mb + 1024 + 4 * lane + 256 * j) + 1.0f; }
        int m = gw;
        if (m < T_) {
#pragma unroll
            for (int j = 0; j < 4; ++j) vn[j] = *(const f32x4*)(xl + (size_t)m * 1024 + 4 * lane + 256 * j);
        }
        for (; m < T_; m += NGW) {
            f32x4 v[4]; float s = 0.f;
#pragma unroll
            for (int j = 0; j < 4; ++j) v[j] = vn[j];
            const int mn = m + NGW;
            if (mn < T_) {
#pragma unroll
                for (int j = 0; j < 4; ++j) vn[j] = *(const f32x4*)(xl + (size_t)mn * 1024 + 4 * lane + 256 * j);
            }
#pragma unroll
            for (int j = 0; j < 4; ++j) s += (v[j][0] * v[j][0] + v[j][1] * v[j][1]) + (v[j][2] * v[j][2] + v[j][3] * v[j][3]);
            const float rstd = rsqrtf(wave_sum(s) * (1.0f / 1024.0f) + 1e-6f);
#pragma unroll
            for (int j = 0; j < 4; ++j) st4bf(HX + (size_t)m * 1024 + 4 * lane + 256 * j, v[j] * rstd * gv[j] * sc[j] + sh[j]);
        }
    }
    for (int m = T_ + gw; m < MT_; m += NGW) {
        float* xr = xc + (size_t)(m - T_) * 1024;
        const float* mb = mods + (size_t)(l * 2 + 1) * 6144 + (ffn ? 3072 : 0);
        f32x4 v[4]; float s = 0.f;
#pragma unroll
        for (int j = 0; j < 4; ++j) v[j] = *(const f32x4*)(xr + 4 * lane + 256 * j);
        if (nparts > 0) {
            for (int sp0 = 0; sp0 < nparts; sp0 += 4) {
                f32x4 pb[4][4];
#pragma unroll
                for (int q = 0; q < 4; ++q) { const int sp = (sp0 + q < nparts) ? sp0 + q : sp0;
#pragma unroll
                    for (int j = 0; j < 4; ++j) pb[q][j] = *(const f32x4*)(part + (size_t)sp * (L_ * D_) + (size_t)(m - T_) * 1024 + 4 * lane + 256 * j); }
                __builtin_amdgcn_sched_barrier(0);
#pragma unroll
                for (int q = 0; q < 4; ++q) { if (sp0 + q < nparts) {
#pragma unroll
                    for (int j = 0; j < 4; ++j) v[j] += pb[q][j]; } }
            }
#pragma unroll
            for (int j = 0; j < 4; ++j) *(f32x4*)(xr + 4 * lane + 256 * j) = v[j];
        }
#pragma unroll
        for (int j = 0; j < 4; ++j) s += (v[j][0] * v[j][0] + v[j][1] * v[j][1]) + (v[j][2] * v[j][2] + v[j][3] * v[j][3]);
        const float rstd = rsqrtf(wave_sum(s) * (1.0f / 1024.0f) + 1e-6f);
#pragma unroll
        for (int j = 0; j < 4; ++j) {
            const f32x4 sh = *(const f32x4*)(mb + 4 * lane + 256 * j), sc = *(const f32x4*)(mb + 1024 + 4 * lane + 256 * j);
            st4bf(HX + (size_t)m * 1024 + 4 * lane + 256 * j, v[j] * rstd * gv[j] * (sc + 1.0f) + sh);
        }
    }
}

__device__ __forceinline__ void phase_dwconv(const LP& p, int j, int nunits, LAS unsigned char* lds) {
    const int tid = otid(), lane = tid & 63, wave = tid >> 6;
    const bf16* Y1 = (const bf16*)(p.ws() + WS_Y1); bf16* Y2 = (bf16*)(p.ws() + WS_Y2);
    const float* dw = p.in(10) + (size_t)j * 31 * 1024; const float* dwb = p.in(11) + j * 1024; const float* ng = p.in(12) + j * 1024;
    LAS float* tile = (LAS float*)lds;
    f32x2 wv[31];
#pragma unroll
    for (int w = 0; w < 31; ++w) wv[w] = *(const f32x2*)(dw + w * 1024 + 2 * tid);
    const f32x2 bb = *(const f32x2*)(dwb + 2 * tid);
    f32x4 gv[4];
#pragma unroll
    for (int q = 0; q < 4; ++q) gv[q] = *(const f32x4*)(ng + 4 * lane + 256 * q);
    for (int u = blockIdx.x; u < nunits; u += gridDim.x) {
        const int t0 = u * 16; const int lo = (t0 < T_) ? 0 : T_, hi = (t0 < T_) ? T_ : MT_;
        f32x2 av[16];
#pragma unroll
        for (int i = 0; i < 16; ++i) av[i] = bb;
        unsigned raws[46];
#pragma unroll
        for (int r = 0; r < 46; ++r) { const int row = t0 - 15 + r; const int rowc = (row >= lo && row < hi) ? row : t0; raws[r] = *(const unsigned*)(Y1 + (size_t)rowc * 1024 + 2 * tid); }
        __builtin_amdgcn_sched_barrier(0);
#pragma unroll
        for (int r = 0; r < 46; ++r) {
            const int row = t0 - 15 + r; const bool inr = (row >= lo && row < hi); const unsigned raw = raws[r];
            f32x2 vv; vv.x = inr ? __uint_as_float(raw << 16) : 0.f; vv.y = inr ? __uint_as_float(raw & 0xffff0000u) : 0.f;
#pragma unroll
            for (int i = 0; i < 16; ++i) { const int w = r - i; if (w >= 0 && w < 31) av[i] = __builtin_elementwise_fma(wv[w], vv, av[i]); }
        }
#pragma unroll
        for (int i = 0; i < 16; ++i) *(LAS f32x2*)(tile + i * 1024 + 2 * tid) = av[i];
        __syncthreads();
#pragma unroll
        for (int ii = 0; ii < 2; ++ii) {
            const int i = wave * 2 + ii;
            f32x4 v[4]; float s = 0.f;
#pragma unroll
            for (int q = 0; q < 4; ++q) { v[q] = *(const LAS f32x4*)(tile + i * 1024 + 4 * lane + 256 * q); s += (v[q][0] + v[q][1]) + (v[q][2] + v[q][3]); }
            const float mean = wave_sum(s) * (1.0f / 1024.0f); float s2 = 0.f;
#pragma unroll
            for (int q = 0; q < 4; ++q) { v[q] = v[q] - mean; s2 += (v[q][0] * v[q][0] + v[q][1] * v[q][1]) + (v[q][2] * v[q][2] + v[q][3] * v[q][3]); }
            const float rstd = rsqrtf(wave_sum(s2) * (1.0f / 1024.0f) + 1e-6f);
#pragma unroll
            for (int q = 0; q < 4; ++q) { f32x4 y = v[q] * rstd * gv[q]; y[0] = silu_f(y[0]); y[1] = silu_f(y[1]); y[2] = silu_f(y[2]); y[3] = silu_f(y[3]);
                st4bf(Y2 + (size_t)(t0 + i) * 1024 + 4 * lane + 256 * q, y); }
        }
        __syncthreads();
    }
}

__device__ __forceinline__ int crow(int r, int hi) { return (r & 3) + 8 * (r >> 2) + 4 * hi; }
__device__ __forceinline__ void phase_attn(const LP& p, int j, LAS unsigned char* lds) {
    const bf16* Q = (const bf16*)(p.ws() + WS_AQ); const bf16* K = (const bf16*)(p.ws() + WS_AK); const bf16* VT = (const bf16*)(p.ws() + WS_AVT); bf16* AO = (bf16*)(p.ws() + WS_AO);
    const float* sink = p.in(21) + j * 16;
    LAS unsigned char* Kl = lds; LAS unsigned char* Vl = lds + 3 * 18432;
    for (int u = blockIdx.x; u < 128 * 4; u += gridDim.x) {
        int tid = threadIdx.x; asm volatile("" : "+v"(tid));
        const int lane = tid & 63, wave = tid >> 6, l31 = lane & 31, hi = lane >> 5;
        const int blk = u >> 2, kh = u & 3; const int rb = 128 * blk;
        const int qh = 4 * kh + (wave >> 1); const int qoff = 64 * (wave & 1);
        bf16x8 qop[2][4];
#pragma unroll
        for (int qt = 0; qt < 2; ++qt)
#pragma unroll
            for (int ks = 0; ks < 4; ++ks) qop[qt][ks] = *(const bf16x8*)(Q + (size_t)(rb + qoff + 32 * qt + l31) * 1024 + 64 * qh + 16 * ks + 8 * hi);
        f32x16 o[2][2]; float lsum[2] = {0.f, 0.f};
#pragma unroll
        for (int a2 = 0; a2 < 2; ++a2)
#pragma unroll
            for (int b = 0; b < 2; ++b)
#pragma unroll
                for (int r = 0; r < 16; ++r) o[a2][b][r] = 0.f;
#pragma unroll 1
        for (int g = 0; g < 2; ++g) {
            if (g == 1 && blk >= 128) break;
            __syncthreads();
#pragma unroll 1
            for (int s3 = 0; s3 < 3 - g; ++s3) {
                const int kb = 3 * g + s3; int kr; bool valid = true;
                if (kb < 2) kr = T_ + 128 * kb; else { const int nb = blk + kb - 3; valid = (blk < 128) && nb >= 0 && nb <= 127; kr = 128 * nb; }
                if (!valid) continue;
                LAS unsigned char* Ks = Kl + s3 * 18432; LAS unsigned char* Vs = Vl + s3 * 17408;
                u32x4 kst2[2], vst2[2];
#pragma unroll
                for (int i = 0; i < 2; ++i) {
                    const int pid = tid + 512 * i;
                    { const int key = pid >> 3, pc = pid & 7; kst2[i] = *(const u32x4*)(K + (size_t)(kr + key) * 256 + 64 * kh + 8 * pc); }
                    { const int d = pid >> 4, pc = pid & 15; vst2[i] = *(const u32x4*)(VT + ((size_t)(kr >> 7) * 256 + 64 * kh + d) * 128 + 8 * pc); }
                }
                __builtin_amdgcn_sched_barrier(0);
#pragma unroll
                for (int i = 0; i < 2; ++i) {
                    const int pid = tid + 512 * i;
                    { const int key = pid >> 3, pc = pid & 7; *(LAS u32x4*)(Ks + key * 144 + 16 * pc) = kst2[i]; }
                    { const int d = pid >> 4, pc = pid & 15; *(LAS u32x4*)(Vs + d * 272 + 16 * pc) = vst2[i]; }
                }
            }
            __syncthreads();
#pragma unroll 1
            for (int s3 = 0; s3 < 3 - g; ++s3) {
                const int kb = 3 * g + s3; int type = 0; bool valid = true;
                if (kb >= 2) { const int nb = blk + kb - 3; valid = (blk < 128) && nb >= 0 && nb <= 127; type = (kb == 2) ? 1 : (kb == 4) ? 2 : 0; }
                if (!valid) continue;
                const LAS unsigned char* Ks = Kl + s3 * 18432; const LAS unsigned char* Vs = Vl + s3 * 17408;
                int l31m = l31, him = hi; asm volatile("" : "+v"(l31m), "+v"(him));
                const int msgn = (type == 1) ? 1 : (type == 2) ? -1 : 0;
#pragma unroll 1
                for (int st = 0; st < 4; ++st) {
                    bf16x8 kf[4];
#pragma unroll
                    for (int ks = 0; ks < 4; ++ks) kf[ks] = *(const LAS bf16x8*)(Ks + (32 * st + l31) * 144 + (16 * ks + 8 * hi) * 2);
                    u32x4 vf[2][2];
#pragma unroll
                    for (int dt = 0; dt < 2; ++dt)
#pragma unroll
                        for (int h2 = 0; h2 < 2; ++h2) {
                            const LAS unsigned char* vb = Vs + (32 * dt + l31) * 272 + (32 * st + 16 * h2 + 4 * hi) * 2;
                            const u32x2 b0 = *(const LAS u32x2*)vb, b1 = *(const LAS u32x2*)(vb + 16);
                            vf[dt][h2] = (u32x4){b0.x, b0.y, b1.x, b1.y};
                        }
#pragma unroll
                    for (int qt = 0; qt < 2; ++qt) {
                        const int a = qoff + 32 * qt + l31m;
                        f32x16 pp;
#pragma unroll
                        for (int r = 0; r < 16; ++r) pp[r] = 0.f;
#pragma unroll
                        for (int ks = 0; ks < 4; ++ks) pp = __builtin_amdgcn_mfma_f32_32x32x16_bf16(kf[ks], qop[qt][ks], pp, 0, 0, 0);
                        float ls = 0.f;
#pragma unroll
                        for (int r = 0; r < 16; ++r) { const int b = 32 * st + crow(r, him); const int dd = msgn * (b - a); const float e = __uint_as_float(__float_as_uint(__expf(pp[r])) & ~(unsigned)(dd >> 31)); pp[r] = e; ls += e; }
                        lsum[qt] += ls;
                        u32x4 pa[2];
#pragma unroll
                        for (int h2 = 0; h2 < 2; ++h2) { pa[h2].x = pk2(pp[8 * h2 + 0], pp[8 * h2 + 1]); pa[h2].y = pk2(pp[8 * h2 + 2], pp[8 * h2 + 3]); pa[h2].z = pk2(pp[8 * h2 + 4], pp[8 * h2 + 5]); pa[h2].w = pk2(pp[8 * h2 + 6], pp[8 * h2 + 7]); }
#pragma unroll
                        for (int dt = 0; dt < 2; ++dt)
#pragma unroll
                            for (int h2 = 0; h2 < 2; ++h2)
                                o[qt][dt] = __builtin_amdgcn_mfma_f32_32x32x16_bf16(__builtin_bit_cast(bf16x8, pa[h2]), __builtin_bit_cast(bf16x8, vf[dt][h2]), o[qt][dt], 0, 0, 0);
                    }
                }
            }
        }
        const float esink = __expf(sink[qh]);
#pragma unroll
        for (int qt = 0; qt < 2; ++qt) {
            float ltot = lsum[qt] + __shfl_xor(lsum[qt], 32);
            const float inv = 1.0f / (ltot + esink);
#pragma unroll
            for (int r = 0; r < 16; ++r) {
                const int qr = crow(r, hi); const float iv = __shfl(inv, qr);
                bf16* op = AO + (size_t)(rb + qoff + 32 * qt + qr) * 1024 + 64 * qh + l31;
                op[0] = (bf16)(pk2(o[qt][0][r] * iv, 0.f) & 0xffffu); op[32] = (bf16)(pk2(o[qt][1][r] * iv, 0.f) & 0xffffu);
            }
        }
    }
}

__device__ __forceinline__ float log_sigmoid_f(float x) { return -log1pf(__expf(-x)); }
struct ScanCtx { int h, dir, sl; float lg; bool active; };
__device__ __forceinline__ void scan_part(const LP& p, const ScanCtx& sc, int part, LAS unsigned char* lds) {
    int tid = threadIdx.x; asm volatile("" : "+v"(tid));
    const int lane = tid & 63, wave = tid >> 6, l31 = lane & 31, hi = lane >> 5, l15 = lane & 15, kq = lane >> 4;
    const bf16* Q = (const bf16*)(p.ws() + WS_RQ); const bf16* KT = (const bf16*)(p.ws() + WS_RKT); const bf16* VT = (const bf16*)(p.ws() + WS_RVT);
    bf16* OI = (bf16*)(p.ws() + WS_ROI); bf16* OIC = (bf16*)(p.ws() + WS_ROIC) + (size_t)sc.dir * 256 * 2048;
    LAS unsigned char* KTl = lds; LAS unsigned char* VTl = lds + 69632; LAS unsigned char* Stl = lds + 69632 + 8704;
    const int h = sc.h, dir = sc.dir, sl = sc.sl; const float lg = sc.lg;
    const float cd = __expf(lg * 128.0f);
    const int nsteps = (part == 0) ? 66 : 64;
    LAS float* kdt = (LAS float*)(lds + 96768); LAS float* qdt = (LAS float*)(lds + 97280);
    if (tid < 128) { const int m = tid; kdt[m] = __expf(lg * (float)(dir ? m : 127 - m)); qdt[m] = __expf(lg * (float)(dir ? 128 - m : m + 1)); }
    u32x4 vreg; bf16x8 kop[8], qA[8], qB[8];
#define SCAN_RB(s) (((part) == 0) ? (((s) < 2) ? (T_ + 128 * (dir ? 1 - (s) : (s))) : 128 * (dir ? 127 - ((s) - 2) : ((s) - 2))) : 128 * (dir ? 63 - (s) : 64 + (s)))
#define SCAN_LOAD_QV(rbv, QN) do { \
        const bf16* vb_ = VT + ((size_t)((rbv) >> 7) * 2048 + 512 * h + 32 * sl) * 128; const bf16* qb_ = Q + (((size_t)((rbv) >> 7) * 4 + h) * 8 + wave) * 4096; \
        vreg = *(const u32x4*)(vb_ + koff); \
        _Pragma("unroll") for (int ks = 0; ks < 8; ++ks) QN[ks] = *(const bf16x8*)(qb_ + ks * 512 + 8 * lane); } while (0)
#define SCAN_LOAD_K(rbv) do { \
        const bf16* kb_ = KT + (((size_t)((rbv) >> 7) * 4 + h) * 8 + wave) * 4096; \
        _Pragma("unroll") for (int ks = 0; ks < 8; ++ks) kop[ks] = *(const bf16x8*)(kb_ + ks * 512 + 8 * lane); } while (0)
    const int koff = (tid >> 4) * 128 + 8 * (tid & 15), qoff = (16 * wave + l15) * 1024 + 8 * kq;
    if (!sc.active) return;
    float* Ssave = (float*)(p.ws() + WS_ROIC + 2 * MiB) + (size_t)(sc.h + 4 * sc.dir + 8 * sc.sl) * 8192 + (size_t)tid * 16;
    f32x16 S;
    if (part == 0) {
#pragma unroll
        for (int r = 0; r < 16; ++r) S[r] = 0.f;
    } else {
#pragma unroll
        for (int r = 0; r < 4; ++r) { const f32x4 t = *(const f32x4*)(Ssave + 4 * r); S[4 * r] = t[0]; S[4 * r + 1] = t[1]; S[4 * r + 2] = t[2]; S[4 * r + 3] = t[3]; }
    }
    LAS int* rbtab = (LAS int*)(lds + 96256);
    if (tid <= nsteps) { const int st_ = (tid < nsteps) ? tid : nsteps - 1; rbtab[tid] = SCAN_RB(st_); }
    __syncthreads();
    { const int rb0 = rfl_i(rbtab[0]); SCAN_LOAD_QV(rb0, qA); SCAN_LOAD_K(rb0); }
    LAS float* const Ow = (LAS float*)(lds + wave * 2304);
    const int orow = lane >> 2, opc = lane & 3;
    u32x4 oiv16 = (u32x4){0u, 0u, 0u, 0u};
    for (int i = 0; i < 9; ++i) Ow[lane + 64 * i] = 0.f;
    typedef __attribute__((address_space(1))) unsigned short g16;
    g16* const WSB = (g16*)p.ws();
    const int ooff = (16 * wave + orow) * 2048 + 512 * h + 32 * sl + 8 * opc;
    size_t pbu = (WS_ROIC + 6 * MiB) / 2;
#define SCAN_FLUSH() do { { \
        const f32x4 w0 = *(const LAS f32x4*)(Ow + orow * 36 + 8 * opc), w1 = *(const LAS f32x4*)(Ow + orow * 36 + 8 * opc + 4); \
        const unsigned rm = (part == 1) ? 0xffffffffu : 0u; \
        u32x4 ov; \
        ov.x = pk2(w0[0] + __uint_as_float((oiv16.x << 16) & rm), w0[1] + __uint_as_float((oiv16.x & 0xffff0000u) & rm)); \
        ov.y = pk2(w0[2] + __uint_as_float((oiv16.y << 16) & rm), w0[3] + __uint_as_float((oiv16.y & 0xffff0000u) & rm)); \
        ov.z = pk2(w1[0] + __uint_as_float((oiv16.z << 16) & rm), w1[1] + __uint_as_float((oiv16.z & 0xffff0000u) & rm)); \
        ov.w = pk2(w1[2] + __uint_as_float((oiv16.w << 16) & rm), w1[3] + __uint_as_float((oiv16.w & 0xffff0000u) & rm)); \
        *(__attribute__((address_space(1))) u32x4*)(WSB + pbu + ooff) = ov; } } while (0)
#define SCAN_STEP(SIDX, QC, QN) do { const int s = (SIDX); \
        const int rb = rfl_i(rbtab[s]); \
        { const int e = tid >> 4, pc = tid & 15; u32x4 w; const f32x4 kda = *(const LAS f32x4*)(kdt + 8 * pc), kdb = *(const LAS f32x4*)(kdt + 8 * pc + 4); const float kd[8] = {kda[0], kda[1], kda[2], kda[3], kdb[0], kdb[1], kdb[2], kdb[3]}; \
          w.x = pk2(__uint_as_float(vreg.x << 16) * kd[0], __uint_as_float(vreg.x & 0xffff0000u) * kd[1]); \
          w.y = pk2(__uint_as_float(vreg.y << 16) * kd[2], __uint_as_float(vreg.y & 0xffff0000u) * kd[3]); \
          w.z = pk2(__uint_as_float(vreg.z << 16) * kd[4], __uint_as_float(vreg.z & 0xffff0000u) * kd[5]); \
          w.w = pk2(__uint_as_float(vreg.w << 16) * kd[6], __uint_as_float(vreg.w & 0xffff0000u) * kd[7]); \
          *(LAS u32x4*)(VTl + e * 272 + 16 * pc) = w; } \
        _Pragma("unroll") for (int g4 = 0; g4 < 4; ++g4) { u32x2 w; w.x = pk2(S[4 * g4 + 0], S[4 * g4 + 1]); w.y = pk2(S[4 * g4 + 2], S[4 * g4 + 3]); \
            *(LAS u32x2*)(Stl + l31 * 528 + (32 * wave + 8 * g4 + 4 * hi) * 2) = w; } \
        SCAN_FLUSH(); \
        __syncthreads(); \
        const size_t obu = (rb >= T_) ? ((WS_ROIC / 2) + (size_t)dir * 256 * 2048 + (size_t)(rb - T_) * 2048) : ((WS_ROI / 2) + (size_t)rb * 2048); \
        oiv16 = *(const __attribute__((address_space(1))) u32x4*)(WSB + obu + ooff); \
        asm volatile("" ::: "memory"); \
        const int rbn = rfl_i(rbtab[s + 1]); \
        SCAN_LOAD_QV(rbn, QN); \
        __builtin_amdgcn_sched_barrier(0); \
        _Pragma("unroll") for (int r = 0; r < 16; ++r) S[r] *= cd; \
        { bf16x8 vb[8]; \
          _Pragma("unroll") for (int ks = 0; ks < 8; ++ks) vb[ks] = *(const LAS bf16x8*)(VTl + l31 * 272 + (16 * ks + 8 * hi) * 2); \
          __builtin_amdgcn_sched_barrier(0); \
          _Pragma("unroll") for (int ks = 0; ks < 8; ++ks) S = __builtin_amdgcn_mfma_f32_32x32x16_bf16(kop[ks], vb[ks], S, 0, 0, 0); } \
        __builtin_amdgcn_sched_barrier(0); \
        SCAN_LOAD_K(rbn); \
        __builtin_amdgcn_sched_barrier(0); \
        _Pragma("unroll") for (int nt = 0; nt < 2; ++nt) { \
            f32x4 acc = (f32x4){0.f, 0.f, 0.f, 0.f}; \
            { bf16x8 sb[8]; \
              _Pragma("unroll") for (int ks = 0; ks < 8; ++ks) sb[ks] = *(const LAS bf16x8*)(Stl + (16 * nt + l15) * 528 + (32 * ks + 8 * kq) * 2); \
              __builtin_amdgcn_sched_barrier(0); \
              _Pragma("unroll") for (int ks = 0; ks < 8; ++ks) acc = __builtin_amdgcn_mfma_f32_16x16x32_bf16(QC[ks], sb[ks], acc, 0, 0, 0); } \
            { const f32x4 qdv = *(const LAS f32x4*)(qdt + 16 * wave + 4 * kq); _Pragma("unroll") for (int jj = 0; jj < 4; ++jj) Ow[(4 * kq + jj) * 36 + 16 * nt + l15] = acc[jj] * qdv[jj]; } } \
        pbu = obu; \
        __syncthreads(); \
    } while (0)
    for (int s2 = 0; s2 < nsteps; s2 += 2) { SCAN_STEP(s2, qA, qB); SCAN_STEP(s2 + 1, qB, qA); }
    SCAN_FLUSH();
#undef SCAN_STEP
#undef SCAN_FLUSH
    if (part == 0) {
#pragma unroll
        for (int r = 0; r < 4; ++r) *(f32x4*)(Ssave + 4 * r) = (f32x4){S[4 * r], S[4 * r + 1], S[4 * r + 2], S[4 * r + 3]};
    }
#undef SCAN_RB
#undef SCAN_LOAD
}

__device__ __forceinline__ void phase_ret_intra(const LP& p, int j, LAS unsigned char* lds, int ubeg, int uend, int bidx, int bstride) {
    const bf16* Q = (const bf16*)(p.ws() + WS_RQ); const bf16* K = (const bf16*)(p.ws() + WS_RK); const bf16* VT = (const bf16*)(p.ws() + WS_RVT);
    bf16* G = (bf16*)(p.ws() + WS_RG); const bf16* OI = (const bf16*)(p.ws() + WS_ROI); const bf16* OIC = (const bf16*)(p.ws() + WS_ROIC);
    LAS unsigned char* Kl = lds; LAS unsigned char* Vl = lds + 67584;
    for (int u = ubeg + bidx; u < uend; u += bstride) {
        int tid = threadIdx.x; asm volatile("" : "+v"(tid));
        const int lane = tid & 63, wave = tid >> 6, l15 = lane & 15, kq = lane >> 4;
        const int c = u >> 2, h = u & 3; const int rb = 128 * c;
        const float lgf = log_sigmoid_f(p.in(15)[j * 4 + h]), lgb = log_sigmoid_f(p.in(16)[j * 4 + h]);
        __syncthreads();
        u32x4 kst[8];
#pragma unroll
        for (int i = 0; i < 8; ++i) { const int pid = tid + 512 * i; const int key = pid >> 5, pc = pid & 31; kst[i] = *(const u32x4*)(K + (size_t)(rb + key) * 1024 + 256 * h + 8 * pc); }
        __builtin_amdgcn_sched_barrier(0);
#pragma unroll
        for (int i = 0; i < 8; ++i) { const int pid = tid + 512 * i; const int key = pid >> 5, pc = pid & 31; *(LAS u32x4*)(Kl + key * 528 + 16 * pc) = kst[i]; }
        bf16x8 qop[8];
#pragma unroll
        for (int ks = 0; ks < 8; ++ks) qop[ks] = *(const bf16x8*)(Q + ((((size_t)(rb >> 7) * 4 + h) * 8 + wave) * 8 + ks) * 512 + 8 * lane);
        __syncthreads();
        u32x2 pk[8];
        const int mq = 16 * wave + l15;
#pragma unroll
        for (int kt = 0; kt < 8; ++kt) {
            f32x4 acc = (f32x4){0.f, 0.f, 0.f, 0.f}; bf16x8 ka[8];
#pragma unroll
            for (int ks = 0; ks < 8; ++ks) ka[ks] = *(const LAS bf16x8*)(Kl + (16 * kt + l15) * 528 + (32 * ks + 8 * kq) * 2);
            __builtin_amdgcn_sched_barrier(0);
#pragma unroll
            for (int ks = 0; ks < 8; ++ks) acc = __builtin_amdgcn_mfma_f32_16x16x32_bf16(ka[ks], qop[ks], acc, 0, 0, 0);
            float pv[4];
#pragma unroll
            for (int jj = 0; jj < 4; ++jj) { const int key = 16 * kt + 4 * kq + jj; const int rel = mq - key;
                const float dcy = (rel > 0) ? __expf(lgf * (float)rel) : (rel < 0) ? __expf(-lgb * (float)rel) : 2.0f; pv[jj] = acc[jj] * dcy; }
            pk[kt].x = pk2(pv[0], pv[1]); pk[kt].y = pk2(pv[2], pv[3]);
        }
        bf16* TMP = (rb >= T_) ? (bf16*)OIC + (size_t)(rb - T_) * 2048 : (bf16*)OI + (size_t)rb * 2048;
        const bool isc = rb >= T_;
        LAS float* Ol = (LAS float*)Kl;
        const int prow = tid >> 2, pseg = tid & 3;
        bf16* TMPr = TMP + (size_t)prow * 2048 + 512 * h;
        float ssp = 0.f;
#pragma unroll 1
        for (int es = 0; es < 4; ++es) {
            __syncthreads();
            u32x4 vst[4];
#pragma unroll
            for (int i = 0; i < 4; ++i) { const int pid = tid + 512 * i; const int e = pid >> 4, pc = pid & 15; vst[i] = *(const u32x4*)(VT + ((size_t)(rb >> 7) * 2048 + 512 * h + 128 * es + e) * 128 + 8 * pc); }
            __builtin_amdgcn_sched_barrier(0);
#pragma unroll
            for (int i = 0; i < 4; ++i) { const int pid = tid + 512 * i; const int e = pid >> 4, pc = pid & 15; *(LAS u32x4*)(Vl + e * 272 + 16 * pc) = vst[i]; }
            __syncthreads();
#pragma unroll
            for (int nt = 0; nt < 8; ++nt) {
                f32x4 acc = (f32x4){0.f, 0.f, 0.f, 0.f}; u32x4 bwv[4];
#pragma unroll
                for (int kp = 0; kp < 4; ++kp) {
                    const LAS unsigned char* vb = Vl + (16 * nt + l15) * 272 + (32 * kp + 4 * kq) * 2;
                    const u32x2 b0 = *(const LAS u32x2*)vb, b1 = *(const LAS u32x2*)(vb + 32);
                    bwv[kp] = (u32x4){b0.x, b0.y, b1.x, b1.y};
                }
                __builtin_amdgcn_sched_barrier(0);
#pragma unroll
                for (int kp = 0; kp < 4; ++kp) {
                    const u32x4 aw = (u32x4){pk[2 * kp].x, pk[2 * kp].y, pk[2 * kp + 1].x, pk[2 * kp + 1].y};
                    acc = __builtin_amdgcn_mfma_f32_16x16x32_bf16(__builtin_bit_cast(bf16x8, aw), __builtin_bit_cast(bf16x8, bwv[kp]), acc, 0, 0, 0);
                }
#pragma unroll
                for (int jj = 0; jj < 4; ++jj) Ol[(16 * wave + 4 * kq + jj) * 132 + 16 * nt + l15] = acc[jj];
            }
            __syncthreads();
            u32x4 oiq[4], ojq[4];
#pragma unroll
            for (int q = 0; q < 4; ++q) { const bf16* tp0 = TMPr + 128 * es + 32 * pseg + 8 * q; oiq[q] = *(const u32x4*)tp0; ojq[q] = (u32x4){0u, 0u, 0u, 0u}; if (isc) ojq[q] = *(const u32x4*)(tp0 + (size_t)256 * 2048); }
            __builtin_amdgcn_sched_barrier(0);
#pragma unroll
            for (int q = 0; q < 4; ++q) {
                const int e0 = 32 * pseg + 8 * q; bf16* tp = TMPr + 128 * es + e0;
                const u32x4 oi = oiq[q];
                const u32x4 oj = ojq[q];
                const f32x4 o0 = *(const LAS f32x4*)(Ol + prow * 132 + e0), o1 = *(const LAS f32x4*)(Ol + prow * 132 + e0 + 4);
                float v[8];
                v[0] = o0[0] + __uint_as_float(oi.x << 16) + __uint_as_float(oj.x << 16); v[1] = o0[1] + __uint_as_float(oi.x & 0xffff0000u) + __uint_as_float(oj.x & 0xffff0000u);
                v[2] = o0[2] + __uint_as_float(oi.y << 16) + __uint_as_float(oj.y << 16); v[3] = o0[3] + __uint_as_float(oi.y & 0xffff0000u) + __uint_as_float(oj.y & 0xffff0000u);
                v[4] = o1[0] + __uint_as_float(oi.z << 16) + __uint_as_float(oj.z << 16); v[5] = o1[1] + __uint_as_float(oi.z & 0xffff0000u) + __uint_as_float(oj.z & 0xffff0000u);
                v[6] = o1[2] + __uint_as_float(oi.w << 16) + __uint_as_float(oj.w << 16); v[7] = o1[3] + __uint_as_float(oi.w & 0xffff0000u) + __uint_as_float(oj.w & 0xffff0000u);
#pragma unroll
                for (int e = 0; e < 8; ++e) ssp += v[e] * v[e];
                u32x4 w; w.x = pk2(v[0], v[1]); w.y = pk2(v[2], v[3]); w.z = pk2(v[4], v[5]); w.w = pk2(v[6], v[7]);
                *(u32x4*)tp = w;
            }
        }
        ssp += __shfl_xor(ssp, 1); ssp += __shfl_xor(ssp, 2);
        const float rstd = rsqrtf(ssp * (1.0f / 512.0f) + 1e-6f);
        bf16* Gr = G + (size_t)(rb + prow) * 2048 + 512 * h;
#pragma unroll
        for (int es = 0; es < 4; ++es) {
            u32x4 tvq[4], gvq[4];
#pragma unroll
            for (int q = 0; q < 4; ++q) { const int col = 128 * es + 32 * pseg + 8 * q; tvq[q] = *(const u32x4*)(TMPr + col); gvq[q] = *(const u32x4*)(Gr + col); }
            __builtin_amdgcn_sched_barrier(0);
#pragma unroll
            for (int q = 0; q < 4; ++q) {
                const int col = 128 * es + 32 * pseg + 8 * q;
                const u32x4 tv = tvq[q], gv = gvq[q];
                u32x4 w;
                w.x = pk2(__uint_as_float(tv.x << 16) * rstd * __uint_as_float(gv.x << 16), __uint_as_float(tv.x & 0xffff0000u) * rstd * __uint_as_float(gv.x & 0xffff0000u));
                w.y = pk2(__uint_as_float(tv.y << 16) * rstd * __uint_as_float(gv.y << 16), __uint_as_float(tv.y & 0xffff0000u) * rstd * __uint_as_float(gv.y & 0xffff0000u));
                w.z = pk2(__uint_as_float(tv.z << 16) * rstd * __uint_as_float(gv.z << 16), __uint_as_float(tv.z & 0xffff0000u) * rstd * __uint_as_float(gv.z & 0xffff0000u));
                w.w = pk2(__uint_as_float(tv.w << 16) * rstd * __uint_as_float(gv.w << 16), __uint_as_float(tv.w & 0xffff0000u) * rstd * __uint_as_float(gv.w & 0xffff0000u));
                *(u32x4*)(Gr + col) = w;
            }
        }
    }
}

#define XB_TMO      128
#define XB_XCNT(j)  (256  + 64 * (j))
#define XB_XSUB(j)  (1280 + 64 * (j))
#define XB_XGEN(j)  (2304 + 64 * (j))
#define XB_TOP      3328
#define XB_TOPGEN   3392
#define XCD_BAR_WORDS 3456
#define XB_SPIN_CAP (1u << 18)

__device__ __forceinline__ unsigned xb_ld(unsigned* p)              { return __hip_atomic_load(p, __ATOMIC_RELAXED, __HIP_MEMORY_SCOPE_AGENT); }
__device__ __forceinline__ unsigned xb_add(unsigned* p, unsigned v) { return __hip_atomic_fetch_add(p, v, __ATOMIC_RELAXED, __HIP_MEMORY_SCOPE_AGENT); }
__device__ __forceinline__ unsigned xb_xcc_id() { return (unsigned)__builtin_amdgcn_s_getreg((3 << 11) | 20) & 0xFu; }
#define XB_SPIN(cond, bar) do { unsigned _sp = 0; while (cond) { __builtin_amdgcn_s_sleep(1); \
    if ((++_sp & 255u) == 0u) { if (xb_ld(&(bar)[XB_TMO])) break; if (_sp > XB_SPIN_CAP) { atomicAdd(&(bar)[XB_TMO], 1u); break; } } } } while (0)

struct XcdBarrier {
    unsigned* bar; unsigned x;
    volatile LAS unsigned* st;
};

__device__ __forceinline__ XcdBarrier xcd_barrier_post(unsigned* bar, volatile LAS unsigned* st) {
    XcdBarrier b; b.bar = bar; b.x = xb_xcc_id(); b.st = st;
    if (threadIdx.x == 0) (void)xb_add(&bar[XB_XCNT(b.x)], 1u);
    return b;
}
__device__ __forceinline__ void xcd_barrier_complete(unsigned* bar, unsigned x, unsigned& nloc, unsigned& nx) {
    const unsigned G = gridDim.x * gridDim.y * gridDim.z;
    unsigned sum, cnt, mine, sp = 0u;
    for (;;) {
        sum = 0u; cnt = 0u; mine = 0u;
#pragma unroll
        for (unsigned j = 0; j < 16; ++j) { const unsigned c = xb_ld(&bar[XB_XCNT(j)]); sum += c; cnt += (c > 0u) ? 1u : 0u; mine = (j == x) ? c : mine; }
        if (sum == G) break;
        __builtin_amdgcn_s_sleep(1);
        if ((++sp & 255u) == 0u) { if (xb_ld(&bar[XB_TMO])) break; if (sp > XB_SPIN_CAP) { atomicAdd(&bar[XB_TMO], 1u); break; } }
    }
    nloc = mine > 0u ? mine : 1u; nx = cnt > 0u ? cnt : 1u;
}

__device__ __forceinline__ void xcd_barrier(const XcdBarrier& b) {
    asm volatile("s_waitcnt vmcnt(0)" ::: "memory");
    __syncthreads();
    if (threadIdx.x == 0) {
        unsigned* bar = b.bar;
        __builtin_amdgcn_s_waitcnt(0);
        unsigned nloc = b.st[0], nx = b.st[1];
        if (nloc == 0u) { xcd_barrier_complete(bar, b.x, nloc, nx); b.st[0] = nloc; b.st[1] = nx; }
        const unsigned old = xb_add(&bar[XB_XSUB(b.x)], 1u);
        const unsigned gen = old / nloc;
        if (old + 1u == (gen + 1u) * nloc) {
            __builtin_amdgcn_fence(__ATOMIC_RELEASE, "agent");
            asm volatile("s_waitcnt vmcnt(0)" ::: "memory");
            const unsigned og = xb_add(&bar[XB_TOP], 1u);
            const unsigned tg = og / nx;
            if (og + 1u == (tg + 1u) * nx) xb_add(&bar[XB_TOPGEN], 1u);
            else XB_SPIN(xb_ld(&bar[XB_TOPGEN]) == tg, bar);
            __builtin_amdgcn_fence(__ATOMIC_ACQUIRE, "agent");
            xb_add(&bar[XB_XGEN(b.x)], 1u);
            asm volatile("s_waitcnt vmcnt(0)" ::: "memory");
        } else {
            XB_SPIN(xb_ld(&bar[XB_XGEN(b.x)]) == gen, bar);
            __builtin_amdgcn_fence(__ATOMIC_ACQUIRE, "agent");
            asm volatile("s_waitcnt vmcnt(0)" ::: "memory");
        }
    }
    __syncthreads();
}

constexpr int XBST_OFF = 131072 + 480;
__global__ void __launch_bounds__(NTHREADS, 2) fwd_megakernel(Params pin) {
    extern __shared__ __attribute__((aligned(16))) unsigned char lds_raw[];
    LAS unsigned char* lds = (LAS unsigned char*)lds_raw;
    cg::grid_group grid = cg::this_grid();
    {
        LAS unsigned long long* lp = (LAS unsigned long long*)(lds + PARAM_OFF);
        if (threadIdx.x < 25) lp[threadIdx.x] = (unsigned long long)pin.in[threadIdx.x];
        if (threadIdx.x == 25) lp[25] = (unsigned long long)pin.out;
        if (threadIdx.x == 26) lp[26] = (unsigned long long)pin.ws;
        __syncthreads();
    }
    LP p; p.q = (const LAS unsigned long long*)(lds + PARAM_OFF);
    if (threadIdx.x < 2) ((volatile LAS unsigned*)(lds + XBST_OFF))[threadIdx.x] = 0u;
    if (threadIdx.x == 0) {
        const unsigned x = xb_xcc_id();
        const unsigned r = __hip_atomic_fetch_add((unsigned*)(pin.ws + WS_BAR + 16384) + 64 * x, 1u, __ATOMIC_RELAXED, __HIP_MEMORY_SCOPE_AGENT);
        *(volatile LAS int*)(lds + VCU_OFF) = (int)(r * 16u + x);
    }
    __syncthreads();
    (void)xcd_barrier_post((unsigned*)(pin.ws + WS_BAR), (volatile LAS unsigned*)(lds + XBST_OFF));
#define GRID_BAR() do { XcdBarrier b_; b_.bar = (unsigned*)(p.ws() + WS_BAR); b_.x = xb_xcc_id(); b_.st = (volatile LAS unsigned*)(lds + XBST_OFF); xcd_barrier(b_); } while (0)
    { const float* cin = p.in(2); float* XC0 = (float*)(p.ws() + WS_XC);
      for (int i = blockIdx.x * NTHREADS + threadIdx.x; i < L_ * D_ / 4; i += gridDim.x * NTHREADS) ((f32x4*)XC0)[i] = ((const f32x4*)cin)[i]; }
    phase_adaln_partial(p);
    convert_mixer(p, 0, lds, (int)blockIdx.x, (int)gridDim.x);
    convert_ffn(p, 0, lds, (int)blockIdx.x, (int)gridDim.x);
    GRID_BAR();
    if (threadIdx.x == 0) {
        const unsigned* rw = (const unsigned*)(p.ws() + WS_BAR + 16384); const unsigned G = gridDim.x; bool ok = (G % 8u) == 0u;
        for (int jx = 0; jx < 8; ++jx) ok = ok && (__hip_atomic_load(rw + 64 * jx, __ATOMIC_RELAXED, __HIP_MEMORY_SCOPE_AGENT) == G / 8u);
        const int pk = *(volatile LAS int*)(lds + VCU_OFF); const int r = pk >> 4, x = pk & 15;
        *(volatile LAS int*)(lds + VCU_OFF) = (ok && x < 8) ? (r * 8 + x) : (int)blockIdx.x;
    }
    __syncthreads();
    phase_adaln_reduce(p);
    GRID_BAR();
    if (gridDim.x == 0x7fffffffu) grid.sync();
#pragma unroll 1
    for (int l = 0; l < 4; ++l) {
#pragma unroll 1
        for (int st = 0; st < 10; ++st) {
            const int kind = l % 3, j = l / 3;
            const bool isg = (st == 1) || (st == 2 && kind != 0) || st == 6 || st == 8 || st == 9;
            const bool did = !((st == 2 && kind == 0) || (st == 4 && kind != 1) || (st == 5 && kind != 1) || (st == 1 && kind != 0));
            if (isg) {
                if (threadIdx.x == 0) {
                    volatile LAS EpiD* e = (volatile LAS EpiD*)(lds + DESC_OFF);
                    unsigned char* ws = p.ws();
                    float* mods = (float*)(ws + WS_MODS); float* XC = (float*)(ws + WS_XC);
                    bf16* HX = (bf16*)(ws + WS_HX); bf16* WM = (bf16*)(ws + WS_WM); bf16* WF = (bf16*)(ws + WS_WF);
                    float* outp = p.out();
                    e->baseL = (l == 0) ? p.in(0) : outp; e->baseC = XC; e->outL = outp; e->outC = XC;
                    e->gateL = mods + (size_t)(l * 2 + 0) * 6144 + 2048; e->gateC = mods + (size_t)(l * 2 + 1) * 6144 + 2048;
                    e->ldc = 1024; e->part = (float*)(ws + WS_R + ((st == 9) ? 100 * MiB : 0));
                    if (st == 1) {
                        e->A = HX; e->Bt = WM; e->M = (l == 3) ? T_ : MT_; e->K = 1024;
                        if (kind == 0) { e->mode = EM_GLU; e->o0 = (bf16*)(ws + WS_Y1); e->bias = p.in(9) + j * 2048; e->N = 2048; }
                        else if (kind == 1) { e->mode = EM_RET; e->o0 = (bf16*)(ws + WS_RQ); e->o1 = (bf16*)(ws + WS_RG); e->o2 = (bf16*)(ws + WS_RK); e->N = 4096; }
                        else { e->mode = EM_ATT; e->o0 = (bf16*)(ws + WS_AQ); e->o1 = (bf16*)(ws + WS_AK); e->gq = p.in(19) + j * 64; e->gk = p.in(20) + j * 64; e->N = 1280; }
                    } else if (st == 2) {
                        e->Bt = HX; e->N = MT_; e->K = 1024;
                        if (kind == 1) { e->mode = EM_RETT; e->o0 = (bf16*)(ws + WS_RKT); e->o1 = (bf16*)(ws + WS_RVT); e->A = WM + (size_t)3072 * 1024; e->M = 3072; }
                        else { e->mode = EM_PLAIN; e->o0 = (bf16*)(ws + WS_AVT); e->ldc = 256; e->A = WM + (size_t)1280 * 1024; e->M = 256; }
                    } else if (st == 6) {
                        e->mode = EM_RES; e->M = (l >= 2) ? T_ : MT_; e->N = 1024;
                        if (kind == 0) { e->A = (const bf16*)(ws + WS_Y2); e->Bt = WM + 4 * MiB / 2; e->K = 1024; }
                        else if (kind == 1) { e->A = (const bf16*)(ws + WS_RG); e->Bt = WM + 12 * MiB / 2; e->K = 2048; }
                        else { e->A = (const bf16*)(ws + WS_AO); e->Bt = WM + 4 * MiB / 2; e->K = 1024; }
                    } else if (st == 8) { e->mode = EM_SWIGLU; e->o0 = (bf16*)(ws + WS_H); e->ldc = F_; e->A = HX; e->Bt = WF; e->M = (l >= 2) ? T_ : MT_; e->N = 2 * F_; e->K = 1024; }
                    else { e->mode = EM_RES; e->A = (const bf16*)(ws + WS_H); e->Bt = WF + 11 * MiB / 2; e->M = (l >= 2) ? T_ : MT_; e->N = 1024; e->K = F_;
                        e->baseL = outp; e->baseC = XC; e->gateL = mods + (size_t)(l * 2 + 0) * 6144 + 5120; e->gateC = mods + (size_t)(l * 2 + 1) * 6144 + 5120; }
                }
                __syncthreads();
                run_gemm(lds);
            } else if (st == 0) {
                float* XC = (float*)(p.ws() + WS_XC);
                phase_norm(p, l, false, (l == 0) ? p.in(0) : p.out(), XC, (const float*)(p.ws() + WS_R + 100 * MiB), (l == 0 || l == 3) ? 0 : 22); if (l > 0 && l != 1) convert_ffn(p, l, lds, (int)blockIdx.x, (int)gridDim.x);
            } else if (st == 7) {
                float* XC = (float*)(p.ws() + WS_XC);
                phase_norm(p, l, true, p.out(), XC, (const float*)(p.ws() + WS_R), (l >= 2) ? 0 : (kind == 1 ? 16 : 8)); if (l < 3 && l != 1) convert_mixer(p, l + 1, lds, (int)blockIdx.x, (int)gridDim.x);
            } else if (st == 3 || st == 4) {
                if (kind == 1) {
#ifndef NO_SCAN
                    ScanCtx sc; const int u = rfl_i(*(volatile LAS int*)(lds + VCU_OFF)); sc.active = u < 128; sc.h = u & 3; sc.dir = (u >> 2) & 1; sc.sl = (u >> 3) & 15;
                    sc.lg = log_sigmoid_f((sc.dir ? p.in(16) : p.in(15))[j * 4 + sc.h]);
                    scan_part(p, sc, st - 3, lds);
#endif
#ifndef NO_INTRA
                    if (st == 4 && u >= 128) phase_ret_intra(p, j, lds, 512, 520, u - 128, 128);
                    if (st == 3 && u >= 128) convert_ffn(p, l, lds, u - 128, (int)gridDim.x - 128);
                    if (st == 4 && u >= 136) { __syncthreads(); convert_mixer(p, l + 1, lds, u - 136, (int)gridDim.x - 136); }
#endif
                } else if (st == 3 && kind == 0) {
#ifndef NO_DW
                    phase_dwconv(p, j, (l == 3) ? T_ / 16 : MT_ / 16, lds);
#endif
                } else if (st == 3) {
#ifndef NO_ATTN
                    phase_attn(p, j, lds);
#endif
                }
            } else if (st == 5 && kind == 1) {
#ifndef NO_INTRA
                phase_ret_intra(p, j, lds, 0, 512, (int)blockIdx.x, (int)gridDim.x);
#endif
            }
            if (did) GRID_BAR();
        }
    }
}

extern "C" void kernel_launch(void* const* d_in, const int* in_sizes, int n_in, void* d_out, int out_size, void* d_ws, size_t ws_size, hipStream_t stream) {
    static int grid_blocks = 0;
    if (grid_blocks == 0) {
        if (n_in != 25 || ws_size < WS_END) { fprintf(stderr, "kernel_launch: unexpected n_in %d / ws_size %zu (need %zu)\n", n_in, ws_size, (size_t)WS_END); grid_blocks = -1; return; }
        int dev = 0, cus = 0, per_cu = 0;
        hipGetDevice(&dev);
        hipDeviceGetAttribute(&cus, hipDeviceAttributeMultiprocessorCount, dev);
        if (hipFuncSetAttribute((const void*)fwd_megakernel, hipFuncAttributeMaxDynamicSharedMemorySize, LDS_BYTES) != hipSuccess) { fprintf(stderr, "kernel_launch: hipFuncSetAttribute failed\n"); grid_blocks = -1; return; }
        hipOccupancyMaxActiveBlocksPerMultiprocessor(&per_cu, (const void*)fwd_megakernel, NTHREADS, LDS_BYTES);
        if (per_cu < 1) { fprintf(stderr, "kernel_launch: occupancy query gives %d\n", per_cu); per_cu = 1; }
        (void)hipGetLastError();
        grid_blocks = cus * 1;
        if (grid_blocks < 128) { fprintf(stderr, "kernel_launch: grid %d too small\n", grid_blocks); grid_blocks = -1; return; }
    }
    if (grid_blocks < 0) return;
    Params p{};
    for (int i = 0; i < 25; ++i) p.in[i] = (const float*)d_in[i];
    p.out = (float*)d_out; p.ws = (unsigned char*)d_ws;
    if (hipMemsetAsync((char*)d_ws + WS_BAR, 0, 32768, stream) != hipSuccess) { fprintf(stderr, "kernel_launch: memset failed\n"); return; }
    void* args[] = {&p};
    hipError_t e = hipLaunchCooperativeKernel((void*)fwd_megakernel, dim3(grid_blocks), dim3(NTHREADS), args, LDS_BYTES, stream);
    if (e != hipSuccess) fprintf(stderr, "cooperative launch failed: %s (grid %d)\n", hipGetErrorString(e), grid_blocks);
}
```

```cpp
#include <hip/hip_runtime.h>
#include <hip/hip_cooperative_groups.h>
#include <cstdio>
#include <cstdint>
namespace cg = cooperative_groups;
namespace pg8 {
#define PG8_LAS __attribute__((address_space(3)))
typedef unsigned short bf16_t;
typedef short bf16x8 __attribute__((ext_vector_type(8)));
typedef float f32x4 __attribute__((ext_vector_type(4)));
typedef unsigned u32x4 __attribute__((ext_vector_type(4)));
constexpr int BM = 256, BK = 64, HALF = 128, HTB = HALF * BK * 2  , STAGE_BYTES = 8 * HTB, NXCD = 8, WGM = 8;

__host__ __device__ __forceinline__ int lds_byte(int r, int c) { const int st = (r >> 4) * 2 + (c >> 5), rr = r & 15, cc = c & 31, ob = rr * 64 + cc * 2; return st * 1024 + (ob ^ (((ob >> 9) & 1) << 5)); }
__host__ __device__ __forceinline__ void stage_rc(int b, int& R, int& C) { const int st = b / 1024, sb = b % 1024, swz = sb ^ (((sb >> 9) & 1) << 5); R = (st >> 1) * 16 + swz / 64; C = (st & 1) * 32 + (swz % 64) / 2; }
__host__ __device__ __forceinline__ int perm32(int rho) { const int n = rho >> 4, i = rho & 15; return 8 * (i >> 2) + 4 * n + (i & 3); }

struct Unit { int pm, pn, kt0, ntu; };
struct Gemm { const bf16_t* A; const bf16_t* Bt; int M, N, K; };

struct StaticOrder {
    int nM, nN, nwg, G, c, ntK, nsplit;
    __host__ __device__ void init(int M, int N, int K, int G_, int c_, int split) { nM = M / BM; nN = N / BM; G = G_; c = c_; ntK = K / BK; nsplit = 0; if (split) { nM -= 1; nsplit = ntK / 2; } nwg = nM * nN; }
    __host__ __device__ __forceinline__ bool next(int i, Unit& u) const {
        const long L = (long)i * G + c;
        int pm, pn, kt0, ntu; bool ok;
        if (L >= nwg) { const int idx = (int)(L - nwg); ok = idx < nN * nsplit; pn = idx % nN; pm = nM; kt0 = 2 * (idx / nN); ntu = 2; }
        else {
            int wgid = (int)L; { const int q = nwg / NXCD, r = nwg % NXCD, xcd = wgid % NXCD, off = wgid / NXCD; wgid = (xcd < r ? xcd * (q + 1) : r * (q + 1) + (xcd - r) * q) + off; }
            const int nig = WGM * nN, gid = wgid / nig, fm = gid * WGM, gsz = (nM - fm) < WGM ? (nM - fm) : WGM;
            pm = fm + ((wgid % nig) % gsz); pn = (wgid % nig) / gsz; kt0 = 0; ntu = ntK; ok = true;
        }
        u.pm = pm; u.pn = pn; u.kt0 = kt0; u.ntu = ntu; return ok;
    }
    __device__ __forceinline__ void a_ready(const Unit&) const {}
    __device__ __forceinline__ void done(const Unit&) const {}
};

__device__ __forceinline__ unsigned cvt_pk_bf16(float lo, float hi) { unsigned r; asm volatile("v_cvt_pk_bf16_f32 %0, %1, %2" : "=v"(r) : "v"(lo), "v"(hi)); return r; }
template <class Epi, class Sched, bool ALIGN_EPI = false, bool SP2 = false>
__device__ __forceinline__ void gemm_phase(PG8_LAS unsigned char* lds, const Gemm g, const Sched& S, const Epi& E) {
    int tid_o = threadIdx.x; asm volatile("" : "+v"(tid_o));
    const int tid = tid_o, wid = __builtin_amdgcn_readfirstlane(tid >> 6), lane = tid & 63, wr = wid >> 2, wc = wid & 3, fr = lane & 15, fq = lane >> 4;
    const int K = g.K, nt = K / BK;
    unsigned voffA[2], voffB[2];
#pragma unroll
    for (int i = 0; i < 2; ++i) { int R, C; stage_rc(tid * 16 + i * 8192, R, C); const int Rb = Epi::PERM ? ((R & ~31) + perm32(R & 31)) : R;
        voffA[i] = (unsigned)(R * K + C) * 2u; voffB[i] = (unsigned)(Rb * K + C) * 2u; }
    const size_t kstep = (size_t)(BK * 2);
    const size_t hstep = (size_t)HALF * K * 2;
    const size_t tstep = 2 * hstep;
    const unsigned ldsw = (unsigned)wid * 1024u;
    const int aoff = lds_byte(wr * 64 + fr, fq * 8), boff = lds_byte(wc * 32 + fr, fq * 8);
#define PG8_SA(b, h) (((b) * 2 + (h)) * HTB)
#define PG8_SB(b, h) ((4 + (b) * 2 + (h)) * HTB)
#define PG8_STAGE(bufoff, gbase, voff) do { _Pragma("unroll") for (int _i = 0; _i < 2; ++_i) \
        __builtin_amdgcn_global_load_lds((const unsigned*)((const char*)(gbase) + (voff)[_i]), (PG8_LAS unsigned*)(lds + (bufoff) + ldsw + _i * 8192), 16, 0, 0); } while (0)
#define PG8_LDA(dst, b, h) do { _Pragma("unroll") for (int m = 0; m < 4; ++m) _Pragma("unroll") for (int k = 0; k < 2; ++k) dst[m][k] = *(const PG8_LAS bf16x8*)(lds + PG8_SA(b, h) + aoff + m * 2048 + k * 1024); } while (0)
#define PG8_LDB(dst, b, h) do { _Pragma("unroll") for (int n = 0; n < 2; ++n) _Pragma("unroll") for (int k = 0; k < 2; ++k) dst[n][k] = *(const PG8_LAS bf16x8*)(lds + PG8_SB(b, h) + boff + n * 2048 + k * 1024); } while (0)
#define PG8_MMA(ai, bj, At, Bt) do { __builtin_amdgcn_s_setprio(1); _Pragma("unroll") for (int m = 0; m < 4; ++m) _Pragma("unroll") for (int n = 0; n < 2; ++n) _Pragma("unroll") for (int k = 0; k < 2; ++k) \
        acc[ai][bj][m][n] = __builtin_amdgcn_mfma_f32_16x16x32_bf16(Bt[n][k], At[m][k], acc[ai][bj][m][n], 0, 0, 0); __builtin_amdgcn_s_setprio(0); } while (0)
#define PG8_WAIT_V(n) asm volatile("s_waitcnt vmcnt(" #n ")" ::: "memory")
#define PG8_WAIT_L(n) asm volatile("s_waitcnt lgkmcnt(" #n ")" ::: "memory")
#define PG8_BAR __builtin_amdgcn_s_barrier()
#define PG8_SCHED __builtin_amdgcn_sched_barrier(0)
    Unit cur, nxt; int ui = 0;
    if (!S.next(0, cur)) return;
    f32x4 acc[2][2][4][2];
#pragma unroll
    for (int a = 0; a < 2; ++a)
#pragma unroll
        for (int b = 0; b < 2; ++b)
#pragma unroll
            for (int m = 0; m < 4; ++m)
#pragma unroll
                for (int n = 0; n < 2; ++n) acc[a][b][m][n] = (f32x4){0.f, 0.f, 0.f, 0.f};
    bf16x8 At[4][2], B0[2][2], B1[2][2];
    const char* cA = (const char*)g.A + (size_t)cur.pm * tstep + (size_t)cur.kt0 * kstep; const char* cB = (const char*)g.Bt + (size_t)cur.pn * tstep + (size_t)cur.kt0 * kstep;
    S.a_ready(cur);
    if constexpr (SP2) {
        PG8_STAGE(PG8_SB(0, 0), cB, voffB); PG8_STAGE(PG8_SB(0, 1), cB + hstep, voffB); PG8_STAGE(PG8_SA(0, 0), cA, voffA); PG8_STAGE(PG8_SA(0, 1), cA + hstep, voffA);
        if (wr == 1) PG8_BAR;
        PG8_WAIT_V(2); PG8_BAR;
        PG8_STAGE(PG8_SB(1, 0), cB + kstep, voffB); PG8_STAGE(PG8_SA(1, 0), cA + kstep, voffA); PG8_STAGE(PG8_SB(1, 1), cB + hstep + kstep, voffB);
        PG8_WAIT_V(6); PG8_BAR;
    } else {
        PG8_STAGE(PG8_SB(0, 0), cB, voffB); PG8_STAGE(PG8_SA(0, 0), cA, voffA); PG8_STAGE(PG8_SB(0, 1), cB + hstep, voffB); PG8_STAGE(PG8_SA(0, 1), cA + hstep, voffA);
        if (wr == 1) PG8_BAR;
        PG8_WAIT_V(4); PG8_BAR;
        PG8_STAGE(PG8_SB(1, 0), cB + kstep, voffB); PG8_STAGE(PG8_SA(1, 0), cA + kstep, voffA); PG8_STAGE(PG8_SB(1, 1), cB + hstep + kstep, voffB);
        PG8_WAIT_V(6); PG8_BAR;
    }
    for (;;) {
        const bool has_next = S.next(ui + 1, nxt);
        const char* nA = has_next ? (const char*)g.A + (size_t)nxt.pm * tstep + (size_t)nxt.kt0 * kstep : cA; const char* nB = has_next ? (const char*)g.Bt + (size_t)nxt.pn * tstep + (size_t)nxt.kt0 * kstep : cB;
        const int ntc = cur.ntu;
        for (int t = 0; t < ntc; t += 2) {
            const bool last = (t == ntc - 2);
            const char* a1 = cA + (size_t)(t + 1) * kstep;
            const char* a2 = last ? nA : cA + (size_t)(t + 2) * kstep; const char* b2 = last ? nB : cB + (size_t)(t + 2) * kstep;
            const char* a3 = a2 + kstep; const char* b3 = b2 + kstep;
            if (last && has_next) S.a_ready(nxt);
            if constexpr (SP2) {
            PG8_LDB(B0, 0, 0); PG8_LDB(B1, 0, 1); PG8_SCHED; PG8_LDA(At, 0, 0); PG8_STAGE(PG8_SA(1, 1), a1 + hstep, voffA);
            PG8_WAIT_V(8); PG8_WAIT_L(0); PG8_BAR; PG8_MMA(0, 0, At, B0); PG8_MMA(0, 1, At, B1); PG8_BAR; PG8_SCHED;
            PG8_LDA(At, 0, 1); PG8_STAGE(PG8_SB(0, 0), b2, voffB); PG8_STAGE(PG8_SB(0, 1), b2 + hstep, voffB); PG8_STAGE(PG8_SA(0, 0), a2, voffA);
            PG8_WAIT_V(8); PG8_WAIT_L(0); PG8_BAR; PG8_MMA(1, 0, At, B0); PG8_MMA(1, 1, At, B1); PG8_BAR; PG8_SCHED;
            PG8_LDB(B0, 1, 0); PG8_LDB(B1, 1, 1); PG8_SCHED; PG8_LDA(At, 1, 0); PG8_STAGE(PG8_SA(0, 1), a2 + hstep, voffA);
            PG8_WAIT_V(8); PG8_WAIT_L(0); PG8_BAR; PG8_MMA(0, 0, At, B0); PG8_MMA(0, 1, At, B1); PG8_BAR; PG8_SCHED;
            PG8_LDA(At, 1, 1); PG8_STAGE(PG8_SB(1, 0), b3, voffB); PG8_STAGE(PG8_SB(1, 1), b3 + hstep, voffB); PG8_STAGE(PG8_SA(1, 0), a3, voffA);
            PG8_WAIT_V(8); PG8_WAIT_L(0); PG8_BAR; PG8_MMA(1, 0, At, B0); PG8_MMA(1, 1, At, B1); PG8_BAR; PG8_SCHED;
            } else {
            PG8_LDB(B0, 0, 0); PG8_SCHED; PG8_LDA(At, 0, 0); PG8_STAGE(PG8_SA(1, 1), a1 + hstep, voffA);
            PG8_WAIT_L(8); PG8_BAR; PG8_WAIT_L(0); PG8_MMA(0, 0, At, B0); PG8_BAR; PG8_SCHED;
            PG8_LDB(B1, 0, 1); PG8_STAGE(PG8_SB(0, 0), b2, voffB);
            PG8_BAR; PG8_WAIT_L(0); PG8_MMA(0, 1, At, B1); PG8_BAR;
            PG8_LDA(At, 0, 1); PG8_STAGE(PG8_SA(0, 0), a2, voffA);
            PG8_BAR; PG8_WAIT_L(0); PG8_MMA(1, 0, At, B0); PG8_BAR; PG8_SCHED;
            PG8_STAGE(PG8_SB(0, 1), b2 + hstep, voffB);
            PG8_WAIT_V(6); PG8_BAR; PG8_MMA(1, 1, At, B1); PG8_BAR;
            PG8_LDB(B0, 1, 0); PG8_SCHED; PG8_LDA(At, 1, 0); PG8_STAGE(PG8_SA(0, 1), a2 + hstep, voffA);
            PG8_WAIT_L(8); PG8_BAR; PG8_WAIT_L(0); PG8_MMA(0, 0, At, B0); PG8_BAR; PG8_SCHED;
            PG8_LDB(B1, 1, 1); PG8_STAGE(PG8_SB(1, 0), b3, voffB);
            PG8_BAR; PG8_WAIT_L(0); PG8_MMA(0, 1, At, B1); PG8_BAR;
            PG8_LDA(At, 1, 1); PG8_STAGE(PG8_SA(1, 0), a3, voffA);
            PG8_BAR; PG8_WAIT_L(0); PG8_MMA(1, 0, At, B0); PG8_BAR; PG8_SCHED;
            PG8_STAGE(PG8_SB(1, 1), b3 + hstep, voffB);
            PG8_WAIT_V(6); PG8_BAR; PG8_MMA(1, 1, At, B1); PG8_BAR;
            }
        }
        if constexpr (ALIGN_EPI) { if (wr == 0) PG8_BAR; }
        if constexpr (!Epi::AFTER_DRAIN) { E(acc, cur, wr, wc, fr, fq); S.done(cur); }
        if (!has_next) break;
#pragma unroll
        for (int a = 0; a < 2; ++a)
#pragma unroll
            for (int b = 0; b < 2; ++b)
#pragma unroll
                for (int m = 0; m < 4; ++m)
#pragma unroll
                    for (int n = 0; n < 2; ++n) acc[a][b][m][n] = (f32x4){0.f, 0.f, 0.f, 0.f};
        cur = nxt; cA = nA; cB = nB; ++ui;
        if constexpr (ALIGN_EPI) { if (wr == 1) PG8_BAR; }
    }
    PG8_WAIT_V(0);
    if constexpr (!ALIGN_EPI) { if (wr == 0) PG8_BAR; }
    PG8_BAR;
    if constexpr (Epi::AFTER_DRAIN) { E.fused(acc, cur, wr, wc, fr, fq, lds, wid, lane); S.done(cur); }
#undef PG8_SA
#undef PG8_SB
#undef PG8_STAGE
#undef PG8_LDA
#undef PG8_LDB
#undef PG8_MMA
#undef PG8_WAIT_V
#undef PG8_WAIT_L
#undef PG8_BAR
#undef PG8_SCHED
}
}

#define LAS __attribute__((address_space(3)))
typedef unsigned short bf16;
typedef short bf16x8 __attribute__((ext_vector_type(8)));
typedef float f32x4 __attribute__((ext_vector_type(4)));
typedef float f32x16 __attribute__((ext_vector_type(16)));
typedef unsigned u32x4 __attribute__((ext_vector_type(4)));
typedef unsigned u32x2 __attribute__((ext_vector_type(2)));
typedef float f32x2 __attribute__((ext_vector_type(2)));

constexpr int T_ = 16384, L_ = 256, MT_ = 16640, D_ = 1024, F_ = 2816;
constexpr int NTHREADS = 512, NWAVES = 8;
constexpr int LDS_BYTES = 131072 + 512;
constexpr int VCU_OFF = 131072 + 496;
constexpr int PARAM_OFF = 131072 + 256;
constexpr size_t MiB = 1u << 20;
constexpr size_t WS_MODS = 0, WS_XC = 1 * MiB, WS_WM = 2 * MiB, WS_WF = 18 * MiB, WS_HX = 35 * MiB, WS_R = 68 * MiB;
constexpr size_t WS_Y1 = WS_R, WS_Y2 = WS_R + 33 * MiB;
constexpr size_t WS_H = WS_R;
constexpr size_t WS_RQ = WS_R, WS_RK = WS_R + 33 * MiB, WS_RG = WS_R + 66 * MiB, WS_RKT = WS_R + 131 * MiB, WS_RVT = WS_R + 164 * MiB,
                 WS_ROI = WS_R + 229 * MiB, WS_ROIC = WS_R + 293 * MiB, WS_END = WS_R + 300 * MiB;
constexpr size_t WS_AQ = WS_R, WS_AK = WS_R + 33 * MiB, WS_AVT = WS_R + 42 * MiB, WS_AO = WS_R + 66 * MiB;
static_assert(WS_END <= 384 * MiB, "ws");
constexpr size_t WS_BAR = 512 * 1024;

struct Params { const float* in[25]; float* out; unsigned char* ws; };
__device__ __forceinline__ int rfl_i(int v) { return __builtin_amdgcn_readfirstlane(v); }
template <class P> __device__ __forceinline__ P rfl_p(P v) { const unsigned long long x = (unsigned long long)v; const unsigned lo = __builtin_amdgcn_readfirstlane((unsigned)x), hi = __builtin_amdgcn_readfirstlane((unsigned)(x >> 32)); return (P)(((unsigned long long)hi << 32) | lo); }
template <class T> __device__ __forceinline__ T* as_global(T* p) { return (T*)(__attribute__((address_space(1))) T*)(unsigned long long)p; }
struct LP {
    const LAS unsigned long long* q;
    __device__ __forceinline__ const float* in(int i) const { return as_global((const float*)rfl_p(q[i])); }
    __device__ __forceinline__ float* out() const { return as_global((float*)rfl_p(q[25])); }
    __device__ __forceinline__ unsigned char* ws() const { return as_global((unsigned char*)rfl_p(q[26])); }
};

__device__ __forceinline__ int otid() { int t = threadIdx.x; asm volatile("" : "+v"(t)); return t; }
__device__ __forceinline__ size_t tr_off(int row, int tok, int NR) { return ((size_t)(tok >> 7) * NR + row) * 128 + (tok & 127); }
__device__ __forceinline__ size_t kt_off(int row, int tok) { const int h = row >> 8, d = row & 255, t = tok & 127;
    return ((((size_t)(tok >> 7) * 4 + h) * 8 + (d >> 5)) * 8 + (t >> 4)) * 512 + ((((t >> 3) & 1) * 32 + (d & 31)) * 8) + (t & 7); }
__device__ __forceinline__ size_t q_off(int row, int h, int sd) { const int t = row & 127;
    return ((((size_t)(row >> 7) * 4 + h) * 8 + (t >> 4)) * 8 + (sd >> 5)) * 512 + ((((sd >> 3) & 3) * 16 + (t & 15)) * 8) + (sd & 7); }
__device__ __forceinline__ float bf2f(unsigned short u) { return __uint_as_float(((unsigned)u) << 16); }
typedef __bf16 bf16x2_t __attribute__((ext_vector_type(2)));
__device__ __forceinline__ unsigned pk2(float lo, float hi) { const f32x2 v = {lo, hi}; const bf16x2_t b = __builtin_convertvector(v, bf16x2_t); return __builtin_bit_cast(unsigned, b); }
__device__ __forceinline__ float silu_f(float x) { return x / (1.0f + __expf(-x)); }
__device__ __forceinline__ float sigmoid_f(float x) { return 1.0f / (1.0f + __expf(-x)); }
__device__ __forceinline__ void st4bf(bf16* p, f32x4 v) { u32x2 w; w.x = pk2(v[0], v[1]); w.y = pk2(v[2], v[3]); *(u32x2*)p = w; }
__device__ __forceinline__ float wave_sum(float v) {
#pragma unroll
    for (int o = 1; o < 64; o <<= 1) v += __shfl_xor(v, o);
    return v;
}

#ifndef EPI_MASK
#define EPI_MASK 0x7f
#endif
#define EPI_ON(m) ((EPI_MASK >> (m)) & 1)
enum { EM_GLU = 0, EM_SWIGLU = 1, EM_RES = 2, EM_RET = 3, EM_RETT = 4, EM_ATT = 5, EM_PLAIN = 6 };
struct EpiD {
    int mode, ldc, M, N, K, pad;
    const bf16* A; const bf16* Bt;
    bf16* o0; bf16* o1; bf16* o2;
    const float* bias; const float* baseL; const float* baseC; float* outL; float* outC;
    const float* gateL; const float* gateC; const float* gq; const float* gk;
    float* part;
};
constexpr int DESC_OFF = 131072;
struct Epi {
    static constexpr bool PERM = false, AFTER_DRAIN = false;
    const LAS EpiD* d;
    __device__ __forceinline__ void operator()(const f32x4 (&acc)[2][2][4][2], const pg8::Unit& u, int wr_, int wc_, int fr_, int fq_) const {
        const int mode = rfl_i(d->mode);
        using namespace pg8;
        int wr = wr_, wc = wc_, fr = fr_, fq = fq_;
        asm volatile("" : "+v"(fr), "+v"(fq)); asm volatile("" : "+s"(wr), "+s"(wc));
        const int rowb = u.pm * BM + wr * 64 + fr;
        const int colb = u.pn * BM + wc * 32 + 4 * fq;
        if ((EPI_ON(EM_GLU) && mode == EM_GLU) || (EPI_ON(EM_SWIGLU) && mode == EM_SWIGLU)) {
            const int ch = u.pn * 128 + wc * 32 + 4 * fq;
            bf16* const o0 = as_global(d->o0); const float* const bias = as_global(d->bias); const int ldc = d->ldc;
            f32x4 ba[2], bg[2];
#pragma unroll
            for (int n = 0; n < 2; ++n) {
                if (mode == EM_GLU) { ba[n] = *(const f32x4*)(bias + ch + 16 * n); bg[n] = *(const f32x4*)(bias + 1024 + ch + 16 * n); }
                else { ba[n] = (f32x4){0.f, 0.f, 0.f, 0.f}; bg[n] = ba[n]; }
            }
#pragma unroll
            for (int ai = 0; ai < 2; ++ai)
#pragma unroll
                for (int m = 0; m < 4; ++m) {
                    bf16* rp = o0 + (size_t)(rowb + ai * HALF + m * 16) * ldc + ch;
#pragma unroll
                    for (int n = 0; n < 2; ++n) {
                        const f32x4 a = acc[ai][0][m][n] + ba[n], g = acc[ai][1][m][n] + bg[n];
                        f32x4 v;
                        if (mode == EM_GLU) { v[0] = a[0] * sigmoid_f(g[0]); v[1] = a[1] * sigmoid_f(g[1]); v[2] = a[2] * sigmoid_f(g[2]); v[3] = a[3] * sigmoid_f(g[3]); }
                        else { v[0] = silu_f(a[0]) * g[0]; v[1] = silu_f(a[1]) * g[1]; v[2] = silu_f(a[2]) * g[2]; v[3] = silu_f(a[3]) * g[3]; }
                        st4bf(rp + 16 * n, v);
                    }
                }
        } else if (EPI_ON(EM_RES) && mode == EM_RES) {
            const bool isc = (u.pm >= T_ / BM);
            const float* gt = isc ? as_global(d->gateC) : as_global(d->gateL);
            f32x4 gv[2][2];
#pragma unroll
            for (int bj = 0; bj < 2; ++bj)
#pragma unroll
                for (int n = 0; n < 2; ++n) gv[bj][n] = *(const f32x4*)(gt + colb + bj * HALF + 16 * n);
            const float* bs = isc ? as_global(d->baseC) : as_global(d->baseL); float* ot = isc ? as_global(d->outC) : as_global(d->outL);
            const int rsub = isc ? T_ : 0;
#pragma unroll
            for (int ai = 0; ai < 2; ++ai)
#pragma unroll
                for (int m = 0; m < 4; ++m) {
                    const size_t off = (size_t)(rowb + ai * HALF + m * 16 - rsub) * D_ + colb;
#pragma unroll
                    for (int bj = 0; bj < 2; ++bj)
#pragma unroll
                        for (int n = 0; n < 2; ++n) {
                            if (isc) {
                                *(f32x4*)(as_global(d->part) + (size_t)(u.kt0 >> 1) * (L_ * D_) + off + bj * HALF + 16 * n) = gv[bj][n] * acc[ai][bj][m][n];
                            } else {
                                const f32x4 b = *(const f32x4*)(bs + off + bj * HALF + 16 * n);
                                *(f32x4*)(ot + off + bj * HALF + 16 * n) = b + gv[bj][n] * acc[ai][bj][m][n];
                            }
                        }
                }
        } else if (EPI_ON(EM_RET) && mode == EM_RET) {
            bf16* const o0 = as_global(d->o0); bf16* const o1 = as_global(d->o1); bf16* const o2 = as_global(d->o2);
            if (u.pn >= 4 && u.pn < 12) {
                const int cg0 = (u.pn - 4) * BM + wc * 32 + 4 * fq;
#pragma unroll
                for (int ai = 0; ai < 2; ++ai)
#pragma unroll
                    for (int m = 0; m < 4; ++m) {
                        bf16* rp = o1 + (size_t)(rowb + ai * HALF + m * 16) * 2048 + cg0;
#pragma unroll
                        for (int bj = 0; bj < 2; ++bj)
#pragma unroll
                            for (int n = 0; n < 2; ++n) { const f32x4 a = acc[ai][bj][m][n]; f32x4 v; v[0] = silu_f(a[0]); v[1] = silu_f(a[1]); v[2] = silu_f(a[2]); v[3] = silu_f(a[3]); st4bf(rp + bj * HALF + 16 * n, v); }
                    }
            } else {
                const bool isk = u.pn >= 12; const int h = u.pn & 3; bf16* ob = isk ? o2 : o0; const float sc = isk ? 0.0625f : 1.0f;
                float inv[2][4];
#pragma unroll
                for (int n = 0; n < 2; ++n)
#pragma unroll
                    for (int e = 0; e < 4; ++e) { const int i = 32 * (wc & 1) + 16 * n + 4 * fq + e; inv[n][e] = exp2f(-(float)i * (13.287712379549449f / 64.0f)); }
                const int j0 = wc * 32 + 4 * fq;
#pragma unroll
                for (int ai = 0; ai < 2; ++ai)
#pragma unroll
                    for (int m = 0; m < 4; ++m) {
                        const int row = rowb + ai * HALF + m * 16;
                        const bool lat = row < T_;
                        const float pos = (float)((wc < 2) ? (row >> 6) : (row & 63));
                        bf16* rp = ob + (size_t)row * 1024 + 256 * h + j0;
#pragma unroll
                        for (int n = 0; n < 2; ++n) {
                            const f32x4 x1 = acc[ai][0][m][n], x2 = acc[ai][1][m][n]; f32x4 r1, r2;
#pragma unroll
                            for (int e = 0; e < 4; ++e) {
                                const float ang = pos * inv[n][e]; float c = __cosf(ang), s = __sinf(ang);
                                if (!lat) { c = 1.f; s = 0.f; }
                                r1[e] = (x1[e] * c - x2[e] * s) * sc; r2[e] = (x2[e] * c + x1[e] * s) * sc;
                            }
                            if (isk) { st4bf(rp + 16 * n, r1); st4bf(rp + 128 + 16 * n, r2); }
                            else { st4bf(ob + q_off(row, h, j0 + 16 * n), r1); st4bf(ob + q_off(row, h, j0 + 16 * n + 128), r2); }
                        }
                    }
            }
        } else if (EPI_ON(EM_RETT) && mode == EM_RETT) {
            bf16* const o0 = as_global(d->o0); bf16* const o1 = as_global(d->o1);
            if (u.pm >= 4) {
#pragma unroll
                for (int ai = 0; ai < 2; ++ai)
#pragma unroll
                    for (int m = 0; m < 4; ++m) {
                        const int vrow = rowb - 4 * BM + ai * HALF + m * 16;
#pragma unroll
                        for (int bj = 0; bj < 2; ++bj)
#pragma unroll
                            for (int n = 0; n < 2; ++n) st4bf(o1 + tr_off(vrow, colb + bj * HALF + 16 * n, 2048), acc[ai][bj][m][n]);
                    }
            } else {
                float inv[4];
#pragma unroll
                for (int m = 0; m < 4; ++m) { const int i = 16 * m + fr; inv[m] = exp2f(-(float)i * (13.287712379549449f / 64.0f)); }
#pragma unroll
                for (int bj = 0; bj < 2; ++bj)
#pragma unroll
                    for (int n = 0; n < 2; ++n) {
                        const int tok0 = colb + bj * HALF + 16 * n;
                        const bool lat = tok0 < T_;
#pragma unroll
                        for (int m = 0; m < 4; ++m) {
                            const f32x4 x1 = acc[0][bj][m][n], x2 = acc[1][bj][m][n]; f32x4 r1, r2;
#pragma unroll
                            for (int e = 0; e < 4; ++e) {
                                const int tok = tok0 + e;
                                const float pos = (float)((wr == 0) ? (tok >> 6) : (tok & 63));
                                const float ang = pos * inv[m]; float c = __cosf(ang), s = __sinf(ang);
                                if (!lat) { c = 1.f; s = 0.f; }
                                r1[e] = (x1[e] * c - x2[e] * s) * 0.0625f; r2[e] = (x2[e] * c + x1[e] * s) * 0.0625f;
                            }
                            const int row = u.pm * BM + wr * 64 + m * 16 + fr;
                            st4bf(o0 + kt_off(row, tok0), r1); st4bf(o0 + kt_off(row + 128, tok0), r2);
                        }
                    }
            }
        } else if (EPI_ON(EM_ATT) && mode == EM_ATT) {
            bf16* const o0 = as_global(d->o0); bf16* const o1 = as_global(d->o1);
            const bool isk = u.pn >= 4; const float* gn = isk ? as_global(d->gk) : as_global(d->gq);
            f32x4 gv[2][2];
#pragma unroll
            for (int bj = 0; bj < 2; ++bj)
#pragma unroll
                for (int n = 0; n < 2; ++n) gv[bj][n] = *(const f32x4*)(gn + 32 * n + 16 * bj + 4 * fq);
            float inv[4];
#pragma unroll
            for (int e = 0; e < 4; ++e) { const int i = 4 * fq + e; inv[e] = exp2f(-(float)i * (13.287712379549449f / 16.0f)); }
            const float sc = isk ? 1.0f : 0.125f;
            bf16* ob = isk ? o1 : o0; const int ld = isk ? 256 : 1024;
            const int cb = (isk ? 0 : u.pn * BM) + 64 * wc + 4 * fq;
#pragma unroll
            for (int ai = 0; ai < 2; ++ai)
#pragma unroll
                for (int m = 0; m < 4; ++m) {
                    const int row = rowb + ai * HALF + m * 16;
                    const bool lat = row < T_;
                    float ss = 0.f;
#pragma unroll
                    for (int bj = 0; bj < 2; ++bj)
#pragma unroll
                        for (int n = 0; n < 2; ++n) { const f32x4 a = acc[ai][bj][m][n]; ss += (a[0] * a[0] + a[1] * a[1]) + (a[2] * a[2] + a[3] * a[3]); }
                    ss += __shfl_xor(ss, 16); ss += __shfl_xor(ss, 32);
                    const float rstd = rsqrtf(ss * (1.0f / 64.0f) + 1e-6f);
                    bf16* rp = ob + (size_t)row * ld + cb;
#pragma unroll
                    for (int n = 0; n < 2; ++n) {
                        const float pos = (float)((n == 0) ? (row >> 6) : (row & 63));
                        const f32x4 y1 = acc[ai][0][m][n] * rstd * gv[0][n], y2 = acc[ai][1][m][n] * rstd * gv[1][n]; f32x4 r1, r2;
#pragma unroll
                        for (int e = 0; e < 4; ++e) {
                            const float ang = pos * inv[e]; float c = __cosf(ang), s = __sinf(ang);
                            if (!lat) { c = 1.f; s = 0.f; }
                            r1[e] = (y1[e] * c - y2[e] * s) * sc; r2[e] = (y2[e] * c + y1[e] * s) * sc;
                        }
                        st4bf(rp + 16 * n, r1); st4bf(rp + 32 + 16 * n, r2);
                    }
                }
        } else if (EPI_ON(EM_PLAIN)) {
            bf16* const o0 = as_global(d->o0); const int ldc = d->ldc;
#pragma unroll
            for (int ai = 0; ai < 2; ++ai)
#pragma unroll
                for (int m = 0; m < 4; ++m) {
                    const int vrow = rowb + ai * HALF + m * 16;
#pragma unroll
                    for (int bj = 0; bj < 2; ++bj)
#pragma unroll
                        for (int n = 0; n < 2; ++n) st4bf(o0 + tr_off(vrow, colb + bj * HALF + 16 * n, ldc), acc[ai][bj][m][n]);
                }
        }
    }
};

__device__ __forceinline__ void run_gemm(LAS unsigned char* lds) {
    const LAS EpiD* d = (const LAS EpiD*)(lds + DESC_OFF);
    const int M = rfl_i(d->M), N = rfl_i(d->N), K = rfl_i(d->K);
    pg8::Gemm g{as_global(rfl_p(d->A)), as_global(rfl_p(d->Bt)), M, N, K}; pg8::StaticOrder S; const int md = rfl_i(d->mode); const int G = (int)gridDim.x;
    const int vcu = rfl_i(*(volatile LAS int*)(lds + VCU_OFF));
    const int cb = (md == EM_RETT || md == EM_PLAIN) ? (int)(((unsigned)vcu + (unsigned)G / 2u) % (unsigned)G) : vcu;
    S.init(M, N, K, G, cb, (md == EM_RES && M == MT_) ? 1 : 0);
    Epi E; E.d = d;
#ifndef NO_GEMM
    pg8::gemm_phase<Epi, pg8::StaticOrder, true, true>(lds, g, S, E);
#endif
    __syncthreads();
}

__device__ __forceinline__ int dest_row(int kind, int n, int N) {
    if (kind == 1) { const int half = N >> 1; if (n < half) return ((n >> 7) << 8) + (n & 127); const int q = n - half; return ((q >> 7) << 8) + 128 + (q & 127); }
    if (kind == 2) {
        if (n < 2048) { const int isk = n >> 10, hn = n & 1023, h = hn >> 8, d = hn & 255, bj = (d >> 6) & 1, j = (d & 63) + ((d >> 7) << 6); return (isk ? 3072 : 0) + 256 * h + 128 * bj + j; }
        if (n < 4096) return 4096 + (n - 2048);
        return 1024 + (n - 4096);
    }
    if (kind == 3) {
        if (n < 1280) { const int isk = n >= 1024; const int hn = isk ? n - 1024 : n; const int head = hn >> 6, d = hn & 63, bj = (d >> 4) & 1, nn = d >> 5, jj = d & 15;
            const int pn = isk ? 4 : (head >> 2), wc = head & 3; return 256 * pn + 128 * bj + 32 * wc + 16 * nn + jj; }
        return n;
    }
    return n;
}
__device__ __forceinline__ void convert_matrix(const float* W, int K, int N, bf16* WT, int kind, LAS float* scr, int gw, int NGW, int lane) {
    const int nblk = N / 32, nitems = (K / 64) * nblk;
    for (int item = gw; item < nitems; item += NGW) {
        const int kb = item / nblk, nb = item % nblk, k0 = 64 * kb, n0 = 32 * nb;
        float wreg[32];
#pragma unroll
        for (int i = 0; i < 32; ++i) { const int kk = 2 * i + (lane >> 5); wreg[i] = W[(size_t)(k0 + kk) * N + n0 + (lane & 31)]; }
        __builtin_amdgcn_sched_barrier(0);
#pragma unroll
        for (int i = 0; i < 32; ++i) { const int kk = 2 * i + (lane >> 5); scr[kk * 33 + (lane & 31)] = wreg[i]; }
        asm volatile("s_waitcnt lgkmcnt(0)" ::: "memory");
        const int c = lane & 7;
#pragma unroll
        for (int j = 0; j < 4; ++j) { const int n = (lane >> 3) + 8 * j; const LAS float* s = scr + (8 * c) * 33 + n;
            u32x4 o; o.x = pk2(s[0 * 33], s[1 * 33]); o.y = pk2(s[2 * 33], s[3 * 33]); o.z = pk2(s[4 * 33], s[5 * 33]); o.w = pk2(s[6 * 33], s[7 * 33]);
            *(u32x4*)(WT + (size_t)dest_row(kind, n0 + n, N) * K + k0 + 8 * c) = o; }
        asm volatile("s_waitcnt lgkmcnt(0)" ::: "memory");
    }
}
__device__ __forceinline__ void convert_mixer(const LP& p, int l, LAS unsigned char* lds, int bidx, int nblk) {
    const int tid = otid(), lane = tid & 63, wave = tid >> 6; const int gw = bidx * NWAVES + wave, NGW = nblk * NWAVES;
    LAS float* scr = (LAS float*)(lds + wave * 8704);
    bf16* wm = (bf16*)(p.ws() + WS_WM);
    const int kind = l % 3, j = l / 3;
    if (kind == 0) {
        convert_matrix(p.in(8) + (size_t)j * 1024 * 2048, 1024, 2048, wm, 1, scr, gw, NGW, lane);
        convert_matrix(p.in(13) + (size_t)j * 1024 * 1024, 1024, 1024, wm + 4 * MiB / 2, 0, scr, gw, NGW, lane);
    } else if (kind == 1) {
        convert_matrix(p.in(14) + (size_t)j * 1024 * 6144, 1024, 6144, wm, 2, scr, gw, NGW, lane);
        convert_matrix(p.in(17) + (size_t)j * 2048 * 1024, 2048, 1024, wm + 12 * MiB / 2, 0, scr, gw, NGW, lane);
    } else {
        convert_matrix(p.in(18) + (size_t)j * 1024 * 1536, 1024, 1536, wm, 3, scr, gw, NGW, lane);
        convert_matrix(p.in(22) + (size_t)j * 1024 * 1024, 1024, 1024, wm + 4 * MiB / 2, 0, scr, gw, NGW, lane);
    }
}
__device__ __forceinline__ void convert_ffn(const LP& p, int l, LAS unsigned char* lds, int bidx, int nblk) {
    const int tid = otid(), lane = tid & 63, wave = tid >> 6; const int gw = bidx * NWAVES + wave, NGW = nblk * NWAVES;
    LAS float* scr = (LAS float*)(lds + wave * 8704);
    bf16* wf = (bf16*)(p.ws() + WS_WF);
    convert_matrix(p.in(23) + (size_t)l * 1024 * 5632, 1024, 5632, wf, 1, scr, gw, NGW, lane);
    convert_matrix(p.in(24) + (size_t)l * 2816 * 1024, 2816, 1024, wf + 11 * MiB / 2, 0, scr, gw, NGW, lane);
}

constexpr size_t WS_ADAP = WS_R;
__device__ __forceinline__ void phase_adaln_partial(const LP& p) {
    const int tid = otid();
    float* part = (float*)(p.ws() + WS_ADAP);
    const float* c = p.in(1); const float* cc = p.in(3);
    for (int u = blockIdx.x; u < 256; u += gridDim.x) {
        const int l = u >> 6, k0 = (u & 63) * 16;
        const float* W = p.in(4) + (size_t)l * 1024 * 6144 + (size_t)k0 * 6144;
        f32x4 a0[3], a1[3];
#pragma unroll
        for (int q = 0; q < 3; ++q) { a0[q] = (f32x4){0.f, 0.f, 0.f, 0.f}; a1[q] = a0[q]; }
#pragma unroll
        for (int hb = 0; hb < 2; ++hb) {
            f32x4 wb[8][3]; float s0[8], s1[8];
#pragma unroll
            for (int kk = 0; kk < 8; ++kk) {
#pragma unroll
                for (int q = 0; q < 3; ++q) wb[kk][q] = *(const f32x4*)(W + (size_t)(8 * hb + kk) * 6144 + 4 * tid + 2048 * q);
                s0[kk] = c[k0 + 8 * hb + kk]; s1[kk] = cc[k0 + 8 * hb + kk];
            }
            __builtin_amdgcn_sched_barrier(0);
#pragma unroll
            for (int kk = 0; kk < 8; ++kk) {
                const float t0 = silu_f(s0[kk]), t1 = silu_f(s1[kk]);
#pragma unroll
                for (int q = 0; q < 3; ++q) { a0[q] += wb[kk][q] * t0; a1[q] += wb[kk][q] * t1; }
            }
        }
#pragma unroll
        for (int q = 0; q < 3; ++q) { *(f32x4*)(part + (size_t)(u * 2 + 0) * 6144 + 4 * tid + 2048 * q) = a0[q]; *(f32x4*)(part + (size_t)(u * 2 + 1) * 6144 + 4 * tid + 2048 * q) = a1[q]; }
    }
}
__device__ __forceinline__ void phase_adaln_reduce(const LP& p) {
    const int tid = otid();
    const float* part = (const float*)(p.ws() + WS_ADAP); float* mods = (float*)(p.ws() + WS_MODS);
    for (int i = blockIdx.x * NTHREADS + tid; i < 4 * 2 * 6144 / 4; i += gridDim.x * NTHREADS) {
        const int l = i / (2 * 1536), r = i % (2 * 1536), sidx = r / 1536, c4 = r % 1536;
        f32x4 acc = *(const f32x4*)(p.in(5) + l * 6144 + 4 * c4);
#pragma unroll 8
        for (int kc = 0; kc < 64; ++kc) acc += *(const f32x4*)(part + (size_t)((l * 64 + kc) * 2 + sidx) * 6144 + 4 * c4);
        *(f32x4*)(mods + (size_t)(l * 2 + sidx) * 6144 + 4 * c4) = acc;
    }
}

__device__ __forceinline__ void phase_norm(const LP& p, int l, bool ffn, const float* xl, float* xc, const float* part, int nparts) {
    const int tid = otid(), lane = tid & 63, wave = tid >> 6; const int gw = blockIdx.x * NWAVES + wave, NGW = gridDim.x * NWAVES;
    const float* mods = (const float*)(p.ws() + WS_MODS);
    const float* g = (ffn ? p.in(7) : p.in(6)) + l * 1024;
    bf16* HX = (bf16*)(p.ws() + WS_HX);
    f32x4 gv[4];
#pragma unroll
    for (int j = 0; j < 4; ++j) gv[j] = *(const f32x4*)(g + 4 * lane + 256 * j);
    {
        const float* mb = mods + (size_t)(l * 2) * 6144 + (ffn ? 3072 : 0);
        f32x4 sh[4], sc[4], vn[4];
#pragma unroll
        for (int j = 0; j < 4; ++j) { sh[j] = *(const f32x4*)(mb + 4 * lane + 256 * j); sc[j] = *(const f32x4*)(mb + 1024 + 4 * lane + 256 * j) + 1.0f; }
        int m = gw;
        if (m < T_) {
#pragma unroll
            for (int j = 0; j < 4; ++j) vn[j] = *(const f32x4*)(xl + (size_t)m * 1024 + 4 * lane + 256 * j);
        }
        for (; m < T_; m += NGW) {
            f32x4 v[4]; float s = 0.f;
#pragma unroll
            for (int j = 0; j < 4; ++j) v[j] = vn[j];
            const int mn = m + NGW;
            if (mn < T_) {
#pragma unroll
                for (int j = 0; j < 4; ++j) vn[j] = *(const f32x4*)(xl + (size_t)mn * 1024 + 4 * lane + 256 * j);
            }
#pragma unroll
            for (int j = 0; j < 4; ++j) s += (v[j][0] * v[j][0] + v[j][1] * v[j][1]) + (v[j][2] * v[j][2] + v[j][3] * v[j][3]);
            const float rstd = rsqrtf(wave_sum(s) * (1.0f / 1024.0f) + 1e-6f);
#pragma unroll
            for (int j = 0; j < 4; ++j) st4bf(HX + (size_t)m * 1024 + 4 * lane + 256 * j, v[j] * rstd * gv[j] * sc[j] + sh[j]);
        }
    }
    for (int m = T_ + gw; m < MT_; m += NGW) {
        float* xr = xc + (size_t)(m - T_) * 1024;
        const float* mb = mods + (size_t)(l * 2 + 1) * 6144 + (ffn ? 3072 : 0);
        f32x4 v[4]; float s = 0.f;
#pragma unroll
        for (int j = 0; j < 4; ++j) v[j] = *(const f32x4*)(xr + 4 * lane + 256 * j);
        if (nparts > 0) {
            for (int sp0 = 0; sp0 < nparts; sp0 += 4) {
                f32x4 pb[4][4];
#pragma unroll
                for (int q = 0; q < 4; ++q) { const int sp = (sp0 + q < nparts) ? sp0 + q : sp0;
#pragma unroll
                    for (int j = 0; j < 4; ++j) pb[q][j] = *(const f32x4*)(part + (size_t)sp * (L_ * D_) + (size_t)(m - T_) * 1024 + 4 * lane + 256 * j); }
                __builtin_amdgcn_sched_barrier(0);
#pragma unroll
                for (int q = 0; q < 4; ++q) { if (sp0 + q < nparts) {
#pragma unroll
                    for (int j = 0; j < 4; ++j) v[j] += pb[q][j]; } }
            }
#pragma unroll
            for (int j = 0; j < 4; ++j) *(f32x4*)(xr + 4 * lane + 256 * j) = v[j];
        }
#pragma unroll
        for (int j = 0; j < 4; ++j) s += (v[j][0] * v[j][0] + v[j][1] * v[j][1]) + (v[j][2] * v[j][2] + v[j][3] * v[j][3]);
        const float rstd = rsqrtf(wave_sum(s) * (1.0f / 1024.0f) + 1e-6f);
#pragma unroll
        for (int j = 0; j < 4; ++j) {
            const f32x4 sh = *(const f32x4*)(mb + 4 * lane + 256 * j), sc = *(const f32x4*)(mb + 1024 + 4 * lane + 256 * j);
            st4bf(HX + (size_t)m * 1024 + 4 * lane + 256 * j, v[j] * rstd * gv[j] * (sc + 1.0f) + sh);
        }
    }
}

__device__ __forceinline__ void phase_dwconv(const LP& p, int j, int nunits, LAS unsigned char* lds) {
    const int tid = otid(), lane = tid & 63, wave = tid >> 6;
    const bf16* Y1 = (const bf16*)(p.ws() + WS_Y1); bf16* Y2 = (bf16*)(p.ws() + WS_Y2);
    const float* dw = p.in(10) + (size_t)j * 31 * 1024; const float* dwb = p.in(11) + j * 1024; const float* ng = p.in(12) + j * 1024;
    LAS float* tile = (LAS float*)lds;
    f32x2 wv[31];
#pragma unroll
    for (int w = 0; w < 31; ++w) wv[w] = *(const f32x2*)(dw + w * 1024 + 2 * tid);
    const f32x2 bb = *(const f32x2*)(dwb + 2 * tid);
    f32x4 gv[4];
#pragma unroll
    for (int q = 0; q < 4; ++q) gv[q] = *(const f32x4*)(ng + 4 * lane + 256 * q);
    const int vcu_d = rfl_i(*(volatile LAS int*)(lds + VCU_OFF)); const bool xl = (gridDim.x == 256);
    const int nit = xl ? ((nunits > 1024 && (vcu_d >> 3) < 2) ? 5 : 4) : (nunits + (int)gridDim.x - 1) / (int)gridDim.x;
    for (int it = 0; it < nit; ++it) {
        const int u = xl ? ((it < 4) ? ((vcu_d & 7) * 128 + (vcu_d >> 3) + 32 * it) : (1024 + (vcu_d & 7) * 2 + (vcu_d >> 3))) : ((int)blockIdx.x + it * (int)gridDim.x);
        if (u >= nunits) break;
        const int t0 = u * 16; const int lo = (t0 < T_) ? 0 : T_, hi = (t0 < T_) ? T_ : MT_;
        f32x2 av[16];
#pragma unroll
        for (int i = 0; i < 16; ++i) av[i] = bb;
        unsigned raws[46];
#pragma unroll
        for (int r = 0; r < 46; ++r) { const int row = t0 - 15 + r; const int rowc = (row >= lo && row < hi) ? row : t0; raws[r] = *(const unsigned*)(Y1 + (size_t)rowc * 1024 + 2 * tid); }
        __builtin_amdgcn_sched_barrier(0);
#pragma unroll
        for (int r = 0; r < 46; ++r) {
            const int row = t0 - 15 + r; const bool inr = (row >= lo && row < hi); const unsigned raw = raws[r];
            f32x2 vv; vv.x = inr ? __uint_as_float(raw << 16) : 0.f; vv.y = inr ? __uint_as_float(raw & 0xffff0000u) : 0.f;
#pragma unroll
            for (int i = 0; i < 16; ++i) { const int w = r - i; if (w >= 0 && w < 31) av[i] = __builtin_elementwise_fma(wv[w], vv, av[i]); }
        }
#pragma unroll
        for (int i = 0; i < 16; ++i) *(LAS f32x2*)(tile + i * 1024 + 2 * tid) = av[i];
        __syncthreads();
#pragma unroll
        for (int ii = 0; ii < 2; ++ii) {
            const int i = wave * 2 + ii;
            f32x4 v[4]; float s = 0.f;
#pragma unroll
            for (int q = 0; q < 4; ++q) { v[q] = *(const LAS f32x4*)(tile + i * 1024 + 4 * lane + 256 * q); s += (v[q][0] + v[q][1]) + (v[q][2] + v[q][3]); }
            const float mean = wave_sum(s) * (1.0f / 1024.0f); float s2 = 0.f;
#pragma unroll
            for (int q = 0; q < 4; ++q) { v[q] = v[q] - mean; s2 += (v[q][0] * v[q][0] + v[q][1] * v[q][1]) + (v[q][2] * v[q][2] + v[q][3] * v[q][3]); }
            const float rstd = rsqrtf(wave_sum(s2) * (1.0f / 1024.0f) + 1e-6f);
#pragma unroll
            for (int q = 0; q < 4; ++q) { f32x4 y = v[q] * rstd * gv[q]; y[0] = silu_f(y[0]); y[1] = silu_f(y[1]); y[2] = silu_f(y[2]); y[3] = silu_f(y[3]);
                st4bf(Y2 + (size_t)(t0 + i) * 1024 + 4 * lane + 256 * q, y); }
        }
        __syncthreads();
    }
}

__device__ __forceinline__ int crow(int r, int hi) { return (r & 3) + 8 * (r >> 2) + 4 * hi; }
__device__ __forceinline__ void phase_attn(const LP& p, int j, LAS unsigned char* lds) {
    const bf16* Q = (const bf16*)(p.ws() + WS_AQ); const bf16* K = (const bf16*)(p.ws() + WS_AK); const bf16* VT = (const bf16*)(p.ws() + WS_AVT); bf16* AO = (bf16*)(p.ws() + WS_AO);
    const float* sink = p.in(21) + j * 16;
    LAS unsigned char* Kl = lds; LAS unsigned char* Vl = lds + 3 * 18432;
    for (int u = blockIdx.x; u < 128 * 4; u += gridDim.x) {
        int tid = threadIdx.x; asm volatile("" : "+v"(tid));
        const int lane = tid & 63, wave = tid >> 6, l31 = lane & 31, hi = lane >> 5;
        const int blk = u >> 2, kh = u & 3; const int rb = 128 * blk;
        const int qh = 4 * kh + (wave >> 1); const int qoff = 64 * (wave & 1);
        bf16x8 qop[2][4];
#pragma unroll
        for (int qt = 0; qt < 2; ++qt)
#pragma unroll
            for (int ks = 0; ks < 4; ++ks) qop[qt][ks] = *(const bf16x8*)(Q + (size_t)(rb + qoff + 32 * qt + l31) * 1024 + 64 * qh + 16 * ks + 8 * hi);
        f32x16 o[2][2]; float lsum[2] = {0.f, 0.f};
#pragma unroll
        for (int a2 = 0; a2 < 2; ++a2)
#pragma unroll
            for (int b = 0; b < 2; ++b)
#pragma unroll
                for (int r = 0; r < 16; ++r) o[a2][b][r] = 0.f;
#pragma unroll 1
        for (int g = 0; g < 2; ++g) {
            if (g == 1 && blk >= 128) break;
            __syncthreads();
#pragma unroll 1
            for (int s3 = 0; s3 < 3 - g; ++s3) {
                const int kb = 3 * g + s3; int kr; bool valid = true;
                if (kb < 2) kr = T_ + 128 * kb; else { const int nb = blk + kb - 3; valid = (blk < 128) && nb >= 0 && nb <= 127; kr = 128 * nb; }
                if (!valid) continue;
                LAS unsigned char* Ks = Kl + s3 * 18432; LAS unsigned char* Vs = Vl + s3 * 17408;
                u32x4 kst2[2], vst2[2];
#pragma unroll
                for (int i = 0; i < 2; ++i) {
                    const int pid = tid + 512 * i;
                    { const int key = pid >> 3, pc = pid & 7; kst2[i] = *(const u32x4*)(K + (size_t)(kr + key) * 256 + 64 * kh + 8 * pc); }
                    { const int d = pid >> 4, pc = pid & 15; vst2[i] = *(const u32x4*)(VT + ((size_t)(kr >> 7) * 256 + 64 * kh + d) * 128 + 8 * pc); }
                }
                __builtin_amdgcn_sched_barrier(0);
#pragma unroll
                for (int i = 0; i < 2; ++i) {
                    const int pid = tid + 512 * i;
                    { const int key = pid >> 3, pc = pid & 7; *(LAS u32x4*)(Ks + key * 144 + 16 * pc) = kst2[i]; }
                    { const int d = pid >> 4, pc = pid & 15; *(LAS u32x4*)(Vs + d * 272 + 16 * pc) = vst2[i]; }
                }
            }
            __syncthreads();
#pragma unroll 1
            for (int s3 = 0; s3 < 3 - g; ++s3) {
                const int kb = 3 * g + s3; int type = 0; bool valid = true;
                if (kb >= 2) { const int nb = blk + kb - 3; valid = (blk < 128) && nb >= 0 && nb <= 127; type = (kb == 2) ? 1 : (kb == 4) ? 2 : 0; }
                if (!valid) continue;
                const LAS unsigned char* Ks = Kl + s3 * 18432; const LAS unsigned char* Vs = Vl + s3 * 17408;
                int l31m = l31, him = hi; asm volatile("" : "+v"(l31m), "+v"(him));
                const int msgn = (type == 1) ? 1 : (type == 2) ? -1 : 0;
#pragma unroll 1
                for (int st = 0; st < 4; ++st) {
                    bf16x8 kf[4];
#pragma unroll
                    for (int ks = 0; ks < 4; ++ks) kf[ks] = *(const LAS bf16x8*)(Ks + (32 * st + l31) * 144 + (16 * ks + 8 * hi) * 2);
                    u32x4 vf[2][2];
#pragma unroll
                    for (int dt = 0; dt < 2; ++dt)
#pragma unroll
                        for (int h2 = 0; h2 < 2; ++h2) {
                            const LAS unsigned char* vb = Vs + (32 * dt + l31) * 272 + (32 * st + 16 * h2 + 4 * hi) * 2;
                            const u32x2 b0 = *(const LAS u32x2*)vb, b1 = *(const LAS u32x2*)(vb + 16);
                            vf[dt][h2] = (u32x4){b0.x, b0.y, b1.x, b1.y};
                        }
#pragma unroll
                    for (int qt = 0; qt < 2; ++qt) {
                        const int a = qoff + 32 * qt + l31m;
                        f32x16 pp;
#pragma unroll
                        for (int r = 0; r < 16; ++r) pp[r] = 0.f;
#pragma unroll
                        for (int ks = 0; ks < 4; ++ks) pp = __builtin_amdgcn_mfma_f32_32x32x16_bf16(kf[ks], qop[qt][ks], pp, 0, 0, 0);
                        float ls = 0.f;
#pragma unroll
                        for (int r = 0; r < 16; ++r) { const int b = 32 * st + crow(r, him); const int dd = msgn * (b - a); const float e = __uint_as_float(__float_as_uint(__expf(pp[r])) & ~(unsigned)(dd >> 31)); pp[r] = e; ls += e; }
                        lsum[qt] += ls;
                        u32x4 pa[2];
#pragma unroll
                        for (int h2 = 0; h2 < 2; ++h2) { pa[h2].x = pk2(pp[8 * h2 + 0], pp[8 * h2 + 1]); pa[h2].y = pk2(pp[8 * h2 + 2], pp[8 * h2 + 3]); pa[h2].z = pk2(pp[8 * h2 + 4], pp[8 * h2 + 5]); pa[h2].w = pk2(pp[8 * h2 + 6], pp[8 * h2 + 7]); }
#pragma unroll
                        for (int dt = 0; dt < 2; ++dt)
#pragma unroll
                            for (int h2 = 0; h2 < 2; ++h2)
                                o[qt][dt] = __builtin_amdgcn_mfma_f32_32x32x16_bf16(__builtin_bit_cast(bf16x8, pa[h2]), __builtin_bit_cast(bf16x8, vf[dt][h2]), o[qt][dt], 0, 0, 0);
                    }
                }
            }
        }
        const float esink = __expf(sink[qh]);
#pragma unroll
        for (int qt = 0; qt < 2; ++qt) {
            float ltot = lsum[qt] + __shfl_xor(lsum[qt], 32);
            const float inv = 1.0f / (ltot + esink);
#pragma unroll
            for (int r = 0; r < 16; ++r) {
                const int qr = crow(r, hi); const float iv = __shfl(inv, qr);
                bf16* op = AO + (size_t)(rb + qoff + 32 * qt + qr) * 1024 + 64 * qh + l31;
                op[0] = (bf16)(pk2(o[qt][0][r] * iv, 0.f) & 0xffffu); op[32] = (bf16)(pk2(o[qt][1][r] * iv, 0.f) & 0xffffu);
            }
        }
    }
}

__device__ __forceinline__ float log_sigmoid_f(float x) { return -log1pf(__expf(-x)); }
struct ScanCtx { int h, dir, sl; float lg; bool active; };
__device__ __forceinline__ void scan_part(const LP& p, const ScanCtx& sc, int part, LAS unsigned char* lds) {
    int tid = threadIdx.x; asm volatile("" : "+v"(tid));
    const int lane = tid & 63, wave = tid >> 6, l31 = lane & 31, hi = lane >> 5, l15 = lane & 15, kq = lane >> 4;
    const bf16* Q = (const bf16*)(p.ws() + WS_RQ); const bf16* KT = (const bf16*)(p.ws() + WS_RKT); const bf16* VT = (const bf16*)(p.ws() + WS_RVT);
    bf16* OI = (bf16*)(p.ws() + WS_ROI); bf16* OIC = (bf16*)(p.ws() + WS_ROIC) + (size_t)sc.dir * 256 * 2048;
    LAS unsigned char* KTl = lds; LAS unsigned char* VTl = lds + 69632; LAS unsigned char* Stl = lds + 69632 + 8704;
    const int h = sc.h, dir = sc.dir, sl = sc.sl; const float lg = sc.lg;
    const float cd = __expf(lg * 128.0f);
    const int nsteps = (part == 0) ? 66 : 64;
    LAS float* kdt = (LAS float*)(lds + 96768); LAS float* qdt = (LAS float*)(lds + 97280);
    if (tid < 128) { const int m = tid; kdt[m] = __expf(lg * (float)(dir ? m : 127 - m)); qdt[m] = __expf(lg * (float)(dir ? 128 - m : m + 1)); }
    u32x4 vreg; bf16x8 kop[8], qA[8], qB[8];
#define SCAN_RB(s) (((part) == 0) ? (((s) < 2) ? (T_ + 128 * (dir ? 1 - (s) : (s))) : 128 * (dir ? 127 - ((s) - 2) : ((s) - 2))) : 128 * (dir ? 63 - (s) : 64 + (s)))
#define SCAN_LOAD_QV(rbv, QN) do { \
        const bf16* vb_ = VT + ((size_t)((rbv) >> 7) * 2048 + 512 * h + 32 * sl) * 128; const bf16* qb_ = Q + (((size_t)((rbv) >> 7) * 4 + h) * 8 + wave) * 4096; \
        vreg = *(const u32x4*)(vb_ + koff); \
        _Pragma("unroll") for (int ks = 0; ks < 8; ++ks) QN[ks] = *(const bf16x8*)(qb_ + ks * 512 + 8 * lane); } while (0)
#define SCAN_LOAD_K(rbv) do { \
        const bf16* kb_ = KT + (((size_t)((rbv) >> 7) * 4 + h) * 8 + wave) * 4096; \
        _Pragma("unroll") for (int ks = 0; ks < 8; ++ks) kop[ks] = *(const bf16x8*)(kb_ + ks * 512 + 8 * lane); } while (0)
    const int koff = (tid >> 4) * 128 + 8 * (tid & 15), qoff = (16 * wave + l15) * 1024 + 8 * kq;
    if (!sc.active) return;
    float* Ssave = (float*)(p.ws() + WS_ROIC + 2 * MiB) + (size_t)(sc.h + 4 * sc.dir + 8 * sc.sl) * 8192 + (size_t)tid * 16;
    f32x16 S;
    if (part == 0) {
#pragma unroll
        for (int r = 0; r < 16; ++r) S[r] = 0.f;
    } else {
#pragma unroll
        for (int r = 0; r < 4; ++r) { const f32x4 t = *(const f32x4*)(Ssave + 4 * r); S[4 * r] = t[0]; S[4 * r + 1] = t[1]; S[4 * r + 2] = t[2]; S[4 * r + 3] = t[3]; }
    }
    LAS int* rbtab = (LAS int*)(lds + 96256);
    if (tid <= nsteps) { const int st_ = (tid < nsteps) ? tid : nsteps - 1; rbtab[tid] = SCAN_RB(st_); }
    __syncthreads();
    { const int rb0 = rfl_i(rbtab[0]); SCAN_LOAD_QV(rb0, qA); SCAN_LOAD_K(rb0); }
    float pend[2][4] = {{0.f, 0.f, 0.f, 0.f}, {0.f, 0.f, 0.f, 0.f}}; unsigned short oiv[2][4] = {{0, 0, 0, 0}, {0, 0, 0, 0}};
    typedef __attribute__((address_space(1))) unsigned short g16;
    g16* const WSB = (g16*)p.ws();
    const int ooff = (16 * wave + 4 * kq) * 2048 + 512 * h + 32 * sl + l15;
    size_t pbu = (WS_ROIC + 6 * MiB) / 2;
#define SCAN_FLUSH() do { { \
        _Pragma("unroll") for (int nt = 0; nt < 2; ++nt) _Pragma("unroll") for (int jj = 0; jj < 4; ++jj) { \
            float v = pend[nt][jj]; v += (part == 1) ? bf2f(oiv[nt][jj]) : 0.f; (WSB + pbu + jj * 2048 + 16 * nt)[ooff] = (unsigned short)(pk2(v, 0.f) & 0xffffu); } } } while (0)
#define SCAN_STEP(SIDX, QC, QN) do { const int s = (SIDX); \
        const int rb = rfl_i(rbtab[s]); \
        { const int e = tid >> 4, pc = tid & 15; u32x4 w; const f32x4 kda = *(const LAS f32x4*)(kdt + 8 * pc), kdb = *(const LAS f32x4*)(kdt + 8 * pc + 4); const float kd[8] = {kda[0], kda[1], kda[2], kda[3], kdb[0], kdb[1], kdb[2], kdb[3]}; \
          w.x = pk2(__uint_as_float(vreg.x << 16) * kd[0], __uint_as_float(vreg.x & 0xffff0000u) * kd[1]); \
          w.y = pk2(__uint_as_float(vreg.y << 16) * kd[2], __uint_as_float(vreg.y & 0xffff0000u) * kd[3]); \
          w.z = pk2(__uint_as_float(vreg.z << 16) * kd[4], __uint_as_float(vreg.z & 0xffff0000u) * kd[5]); \
          w.w = pk2(__uint_as_float(vreg.w << 16) * kd[6], __uint_as_float(vreg.w & 0xffff0000u) * kd[7]); \
          *(LAS u32x4*)(VTl + e * 272 + 16 * pc) = w; } \
        _Pragma("unroll") for (int g4 = 0; g4 < 4; ++g4) { u32x2 w; w.x = pk2(S[4 * g4 + 0], S[4 * g4 + 1]); w.y = pk2(S[4 * g4 + 2], S[4 * g4 + 3]); \
            *(LAS u32x2*)(Stl + l31 * 528 + (32 * wave + 8 * g4 + 4 * hi) * 2) = w; } \
        SCAN_FLUSH(); \
        __syncthreads(); \
        const size_t obu = (rb >= T_) ? ((WS_ROIC / 2) + (size_t)dir * 256 * 2048 + (size_t)(rb - T_) * 2048) : ((WS_ROI / 2) + (size_t)rb * 2048); \
        _Pragma("unroll") for (int nt = 0; nt < 2; ++nt) _Pragma("unroll") for (int jj = 0; jj < 4; ++jj) oiv[nt][jj] = (WSB + obu + jj * 2048 + 16 * nt)[ooff]; \
        asm volatile("" ::: "memory"); \
        const int rbn = rfl_i(rbtab[s + 1]); \
        SCAN_LOAD_QV(rbn, QN); \
        __builtin_amdgcn_sched_barrier(0); \
        _Pragma("unroll") for (int r = 0; r < 16; ++r) S[r] *= cd; \
        { bf16x8 vb[8]; \
          _Pragma("unroll") for (int ks = 0; ks < 8; ++ks) vb[ks] = *(const LAS bf16x8*)(VTl + l31 * 272 + (16 * ks + 8 * hi) * 2); \
          __builtin_amdgcn_sched_barrier(0); \
          _Pragma("unroll") for (int ks = 0; ks < 8; ++ks) S = __builtin_amdgcn_mfma_f32_32x32x16_bf16(kop[ks], vb[ks], S, 0, 0, 0); } \
        __builtin_amdgcn_sched_barrier(0); \
        SCAN_LOAD_K(rbn); \
        __builtin_amdgcn_sched_barrier(0); \
        _Pragma("unroll") for (int nt = 0; nt < 2; ++nt) { \
            f32x4 acc = (f32x4){0.f, 0.f, 0.f, 0.f}; \
            { bf16x8 sb[8]; \
              _Pragma("unroll") for (int ks = 0; ks < 8; ++ks) sb[ks] = *(const LAS bf16x8*)(Stl + (16 * nt + l15) * 528 + (32 * ks + 8 * kq) * 2); \
              __builtin_amdgcn_sched_barrier(0); \
              _Pragma("unroll") for (int ks = 0; ks < 8; ++ks) acc = __builtin_amdgcn_mfma_f32_16x16x32_bf16(QC[ks], sb[ks], acc, 0, 0, 0); } \
            { const f32x4 qdv = *(const LAS f32x4*)(qdt + 16 * wave + 4 * kq); _Pragma("unroll") for (int jj = 0; jj < 4; ++jj) pend[nt][jj] = acc[jj] * qdv[jj]; } } \
        pbu = obu; \
        __syncthreads(); \
    } while (0)
    for (int s2 = 0; s2 < nsteps; s2 += 2) { SCAN_STEP(s2, qA, qB); SCAN_STEP(s2 + 1, qB, qA); }
    SCAN_FLUSH();
#undef SCAN_STEP
#undef SCAN_FLUSH
    if (part == 0) {
#pragma unroll
        for (int r = 0; r < 4; ++r) *(f32x4*)(Ssave + 4 * r) = (f32x4){S[4 * r], S[4 * r + 1], S[4 * r + 2], S[4 * r + 3]};
    }
#undef SCAN_RB
#undef SCAN_LOAD
}

__device__ __forceinline__ void phase_ret_intra(const LP& p, int j, LAS unsigned char* lds, int ubeg, int uend, int bidx, int bstride) {
    const bf16* Q = (const bf16*)(p.ws() + WS_RQ); const bf16* K = (const bf16*)(p.ws() + WS_RK); const bf16* VT = (const bf16*)(p.ws() + WS_RVT);
    bf16* G = (bf16*)(p.ws() + WS_RG); const bf16* OI = (const bf16*)(p.ws() + WS_ROI); const bf16* OIC = (const bf16*)(p.ws() + WS_ROIC);
    LAS unsigned char* Kl = lds; LAS unsigned char* Vl = lds + 67584;
    for (int u = ubeg + bidx; u < uend; u += bstride) {
        int tid = threadIdx.x; asm volatile("" : "+v"(tid));
        const int lane = tid & 63, wave = tid >> 6, l15 = lane & 15, kq = lane >> 4;
        const int c = u >> 2, h = u & 3; const int rb = 128 * c;
        const float lgf = log_sigmoid_f(p.in(15)[j * 4 + h]), lgb = log_sigmoid_f(p.in(16)[j * 4 + h]);
        __syncthreads();
        u32x4 kst[8];
#pragma unroll
        for (int i = 0; i < 8; ++i) { const int pid = tid + 512 * i; const int key = pid >> 5, pc = pid & 31; kst[i] = *(const u32x4*)(K + (size_t)(rb + key) * 1024 + 256 * h + 8 * pc); }
        __builtin_amdgcn_sched_barrier(0);
#pragma unroll
        for (int i = 0; i < 8; ++i) { const int pid = tid + 512 * i; const int key = pid >> 5, pc = pid & 31; *(LAS u32x4*)(Kl + key * 528 + 16 * pc) = kst[i]; }
        bf16x8 qop[8];
#pragma unroll
        for (int ks = 0; ks < 8; ++ks) qop[ks] = *(const bf16x8*)(Q + ((((size_t)(rb >> 7) * 4 + h) * 8 + wave) * 8 + ks) * 512 + 8 * lane);
        __syncthreads();
        u32x2 pk[8];
        const int mq = 16 * wave + l15;
#pragma unroll
        for (int kt = 0; kt < 8; ++kt) {
            f32x4 acc = (f32x4){0.f, 0.f, 0.f, 0.f}; bf16x8 ka[8];
#pragma unroll
            for (int ks = 0; ks < 8; ++ks) ka[ks] = *(const LAS bf16x8*)(Kl + (16 * kt + l15) * 528 + (32 * ks + 8 * kq) * 2);
            __builtin_amdgcn_sched_barrier(0);
#pragma unroll
            for (int ks = 0; ks < 8; ++ks) acc = __builtin_amdgcn_mfma_f32_16x16x32_bf16(ka[ks], qop[ks], acc, 0, 0, 0);
            float pv[4];
#pragma unroll
            for (int jj = 0; jj < 4; ++jj) { const int key = 16 * kt + 4 * kq + jj; const int rel = mq - key;
                const float dcy = (rel > 0) ? __expf(lgf * (float)rel) : (rel < 0) ? __expf(-lgb * (float)rel) : 2.0f; pv[jj] = acc[jj] * dcy; }
            pk[kt].x = pk2(pv[0], pv[1]); pk[kt].y = pk2(pv[2], pv[3]);
        }
        bf16* TMP = (rb >= T_) ? (bf16*)OIC + (size_t)(rb - T_) * 2048 : (bf16*)OI + (size_t)rb * 2048;
        const bool isc = rb >= T_;
        LAS float* Ol = (LAS float*)Kl;
        const int prow = tid >> 2, pseg = tid & 3;
        bf16* TMPr = TMP + (size_t)prow * 2048 + 512 * h;
        float ssp = 0.f;
#pragma unroll 1
        for (int es = 0; es < 4; ++es) {
            __syncthreads();
            u32x4 vst[4];
#pragma unroll
            for (int i = 0; i < 4; ++i) { const int pid = tid + 512 * i; const int e = pid >> 4, pc = pid & 15; vst[i] = *(const u32x4*)(VT + ((size_t)(rb >> 7) * 2048 + 512 * h + 128 * es + e) * 128 + 8 * pc); }
            __builtin_amdgcn_sched_barrier(0);
#pragma unroll
            for (int i = 0; i < 4; ++i) { const int pid = tid + 512 * i; const int e = pid >> 4, pc = pid & 15; *(LAS u32x4*)(Vl + e * 272 + 16 * pc) = vst[i]; }
            __syncthreads();
#pragma unroll
            for (int nt = 0; nt < 8; ++nt) {
                f32x4 acc = (f32x4){0.f, 0.f, 0.f, 0.f}; u32x4 bwv[4];
#pragma unroll
                for (int kp = 0; kp < 4; ++kp) {
                    const LAS unsigned char* vb = Vl + (16 * nt + l15) * 272 + (32 * kp + 4 * kq) * 2;
                    const u32x2 b0 = *(const LAS u32x2*)vb, b1 = *(const LAS u32x2*)(vb + 32);
                    bwv[kp] = (u32x4){b0.x, b0.y, b1.x, b1.y};
                }
                __builtin_amdgcn_sched_barrier(0);
#pragma unroll
                for (int kp = 0; kp < 4; ++kp) {
                    const u32x4 aw = (u32x4){pk[2 * kp].x, pk[2 * kp].y, pk[2 * kp + 1].x, pk[2 * kp + 1].y};
                    acc = __builtin_amdgcn_mfma_f32_16x16x32_bf16(__builtin_bit_cast(bf16x8, aw), __builtin_bit_cast(bf16x8, bwv[kp]), acc, 0, 0, 0);
                }
#pragma unroll
                for (int jj = 0; jj < 4; ++jj) Ol[(16 * wave + 4 * kq + jj) * 132 + 16 * nt + l15] = acc[jj];
            }
            __syncthreads();
            u32x4 oiq[4], ojq[4];
#pragma unroll
            for (int q = 0; q < 4; ++q) { const bf16* tp0 = TMPr + 128 * es + 32 * pseg + 8 * q; oiq[q] = *(const u32x4*)tp0; ojq[q] = (u32x4){0u, 0u, 0u, 0u}; if (isc) ojq[q] = *(const u32x4*)(tp0 + (size_t)256 * 2048); }
            __builtin_amdgcn_sched_barrier(0);
#pragma unroll
            for (int q = 0; q < 4; ++q) {
                const int e0 = 32 * pseg + 8 * q; bf16* tp = TMPr + 128 * es + e0;
                const u32x4 oi = oiq[q];
                const u32x4 oj = ojq[q];
                const f32x4 o0 = *(const LAS f32x4*)(Ol + prow * 132 + e0), o1 = *(const LAS f32x4*)(Ol + prow * 132 + e0 + 4);
                float v[8];
                v[0] = o0[0] + __uint_as_float(oi.x << 16) + __uint_as_float(oj.x << 16); v[1] = o0[1] + __uint_as_float(oi.x & 0xffff0000u) + __uint_as_float(oj.x & 0xffff0000u);
                v[2] = o0[2] + __uint_as_float(oi.y << 16) + __uint_as_float(oj.y << 16); v[3] = o0[3] + __uint_as_float(oi.y & 0xffff0000u) + __uint_as_float(oj.y & 0xffff0000u);
                v[4] = o1[0] + __uint_as_float(oi.z << 16) + __uint_as_float(oj.z << 16); v[5] = o1[1] + __uint_as_float(oi.z & 0xffff0000u) + __uint_as_float(oj.z & 0xffff0000u);
                v[6] = o1[2] + __uint_as_float(oi.w << 16) + __uint_as_float(oj.w << 16); v[7] = o1[3] + __uint_as_float(oi.w & 0xffff0000u) + __uint_as_float(oj.w & 0xffff0000u);
#pragma unroll
                for (int e = 0; e < 8; ++e) ssp += v[e] * v[e];
                u32x4 w; w.x = pk2(v[0], v[1]); w.y = pk2(v[2], v[3]); w.z = pk2(v[4], v[5]); w.w = pk2(v[6], v[7]);
                *(u32x4*)tp = w;
            }
        }
        ssp += __shfl_xor(ssp, 1); ssp += __shfl_xor(ssp, 2);
        const float rstd = rsqrtf(ssp * (1.0f / 512.0f) + 1e-6f);
        bf16* Gr = G + (size_t)(rb + prow) * 2048 + 512 * h;
#pragma unroll
        for (int es = 0; es < 4; ++es) {
            u32x4 tvq[4], gvq[4];
#pragma unroll
            for (int q = 0; q < 4; ++q) { const int col = 128 * es + 32 * pseg + 8 * q; tvq[q] = *(const u32x4*)(TMPr + col); gvq[q] = *(const u32x4*)(Gr + col); }
            __builtin_amdgcn_sched_barrier(0);
#pragma unroll
            for (int q = 0; q < 4; ++q) {
                const int col = 128 * es + 32 * pseg + 8 * q;
                const u32x4 tv = tvq[q], gv = gvq[q];
                u32x4 w;
                w.x = pk2(__uint_as_float(tv.x << 16) * rstd * __uint_as_float(gv.x << 16), __uint_as_float(tv.x & 0xffff0000u) * rstd * __uint_as_float(gv.x & 0xffff0000u));
                w.y = pk2(__uint_as_float(tv.y << 16) * rstd * __uint_as_float(gv.y << 16), __uint_as_float(tv.y & 0xffff0000u) * rstd * __uint_as_float(gv.y & 0xffff0000u));
                w.z = pk2(__uint_as_float(tv.z << 16) * rstd * __uint_as_float(gv.z << 16), __uint_as_float(tv.z & 0xffff0000u) * rstd * __uint_as_float(gv.z & 0xffff0000u));
                w.w = pk2(__uint_as_float(tv.w << 16) * rstd * __uint_as_float(gv.w << 16), __uint_as_float(tv.w & 0xffff0000u) * rstd * __uint_as_float(gv.w & 0xffff0000u));
                *(u32x4*)(Gr + col) = w;
            }
        }
    }
}

#define XB_TMO      128
#define XB_XCNT(j)  (256  + 64 * (j))
#define XB_XSUB(j)  (1280 + 64 * (j))
#define XB_XGEN(j)  (2304 + 64 * (j))
#define XB_TOP      3328
#define XB_TOPGEN   3392
#define XCD_BAR_WORDS 3456
#define XB_SPIN_CAP (1u << 18)

__device__ __forceinline__ unsigned xb_ld(unsigned* p)              { return __hip_atomic_load(p, __ATOMIC_RELAXED, __HIP_MEMORY_SCOPE_AGENT); }
__device__ __forceinline__ unsigned xb_add(unsigned* p, unsigned v) { return __hip_atomic_fetch_add(p, v, __ATOMIC_RELAXED, __HIP_MEMORY_SCOPE_AGENT); }
__device__ __forceinline__ unsigned xb_xcc_id() { return (unsigned)__builtin_amdgcn_s_getreg((3 << 11) | 20) & 0xFu; }
#define XB_SPIN(cond, bar) do { unsigned _sp = 0; while (cond) { __builtin_amdgcn_s_sleep(1); \
    if ((++_sp & 255u) == 0u) { if (xb_ld(&(bar)[XB_TMO])) break; if (_sp > XB_SPIN_CAP) { atomicAdd(&(bar)[XB_TMO], 1u); break; } } } } while (0)

struct XcdBarrier {
    unsigned* bar; unsigned x;
    volatile LAS unsigned* st;
};

__device__ __forceinline__ XcdBarrier xcd_barrier_post(unsigned* bar, volatile LAS unsigned* st) {
    XcdBarrier b; b.bar = bar; b.x = xb_xcc_id(); b.st = st;
    if (threadIdx.x == 0) (void)xb_add(&bar[XB_XCNT(b.x)], 1u);
    return b;
}
__device__ __forceinline__ void xcd_barrier_complete(unsigned* bar, unsigned x, unsigned& nloc, unsigned& nx) {
    const unsigned G = gridDim.x * gridDim.y * gridDim.z;
    unsigned sum, cnt, mine, sp = 0u;
    for (;;) {
        sum = 0u; cnt = 0u; mine = 0u;
#pragma unroll
        for (unsigned j = 0; j < 16; ++j) { const unsigned c = xb_ld(&bar[XB_XCNT(j)]); sum += c; cnt += (c > 0u) ? 1u : 0u; mine = (j == x) ? c : mine; }
        if (sum == G) break;
        __builtin_amdgcn_s_sleep(1);
        if ((++sp & 255u) == 0u) { if (xb_ld(&bar[XB_TMO])) break; if (sp > XB_SPIN_CAP) { atomicAdd(&bar[XB_TMO], 1u); break; } }
    }
    nloc = mine > 0u ? mine : 1u; nx = cnt > 0u ? cnt : 1u;
}

__device__ __forceinline__ void xcd_barrier(const XcdBarrier& b) {
    asm volatile("s_waitcnt vmcnt(0)" ::: "memory");
    __syncthreads();
    if (threadIdx.x == 0) {
        unsigned* bar = b.bar;
        __builtin_amdgcn_s_waitcnt(0);
        unsigned nloc = b.st[0], nx = b.st[1];
        if (nloc == 0u) { xcd_barrier_complete(bar, b.x, nloc, nx); b.st[0] = nloc; b.st[1] = nx; }
        const unsigned old = xb_add(&bar[XB_XSUB(b.x)], 1u);
        const unsigned gen = old / nloc;
        if (old + 1u == (gen + 1u) * nloc) {
            __builtin_amdgcn_fence(__ATOMIC_RELEASE, "agent");
            asm volatile("s_waitcnt vmcnt(0)" ::: "memory");
            const unsigned og = xb_add(&bar[XB_TOP], 1u);
            const unsigned tg = og / nx;
            if (og + 1u == (tg + 1u) * nx) xb_add(&bar[XB_TOPGEN], 1u);
            else XB_SPIN(xb_ld(&bar[XB_TOPGEN]) == tg, bar);
            __builtin_amdgcn_fence(__ATOMIC_ACQUIRE, "agent");
            xb_add(&bar[XB_XGEN(b.x)], 1u);
            asm volatile("s_waitcnt vmcnt(0)" ::: "memory");
        } else {
            XB_SPIN(xb_ld(&bar[XB_XGEN(b.x)]) == gen, bar);
            __builtin_amdgcn_fence(__ATOMIC_ACQUIRE, "agent");
            asm volatile("s_waitcnt vmcnt(0)" ::: "memory");
        }
    }
    __syncthreads();
}

constexpr int XBST_OFF = 131072 + 480;
__global__ void __launch_bounds__(NTHREADS, 2) fwd_megakernel(Params pin) {
    extern __shared__ __attribute__((aligned(16))) unsigned char lds_raw[];
    LAS unsigned char* lds = (LAS unsigned char*)lds_raw;
    cg::grid_group grid = cg::this_grid();
    {
        LAS unsigned long long* lp = (LAS unsigned long long*)(lds + PARAM_OFF);
        if (threadIdx.x < 25) lp[threadIdx.x] = (unsigned long long)pin.in[threadIdx.x];
        if (threadIdx.x == 25) lp[25] = (unsigned long long)pin.out;
        if (threadIdx.x == 26) lp[26] = (unsigned long long)pin.ws;
        __syncthreads();
    }
    LP p; p.q = (const LAS unsigned long long*)(lds + PARAM_OFF);
    if (threadIdx.x < 2) ((volatile LAS unsigned*)(lds + XBST_OFF))[threadIdx.x] = 0u;
    if (threadIdx.x == 0) {
        const unsigned x = xb_xcc_id();
        const unsigned r = __hip_atomic_fetch_add((unsigned*)(pin.ws + WS_BAR + 16384) + 64 * x, 1u, __ATOMIC_RELAXED, __HIP_MEMORY_SCOPE_AGENT);
        *(volatile LAS int*)(lds + VCU_OFF) = (int)(r * 16u + x);
    }
    __syncthreads();
    (void)xcd_barrier_post((unsigned*)(pin.ws + WS_BAR), (volatile LAS unsigned*)(lds + XBST_OFF));
#define GRID_BAR() do { XcdBarrier b_; b_.bar = (unsigned*)(p.ws() + WS_BAR); b_.x = xb_xcc_id(); b_.st = (volatile LAS unsigned*)(lds + XBST_OFF); xcd_barrier(b_); } while (0)
    { const float* cin = p.in(2); float* XC0 = (float*)(p.ws() + WS_XC);
      for (int i = blockIdx.x * NTHREADS + threadIdx.x; i < L_ * D_ / 4; i += gridDim.x * NTHREADS) ((f32x4*)XC0)[i] = ((const f32x4*)cin)[i]; }
    phase_adaln_partial(p);
    convert_mixer(p, 0, lds, (int)blockIdx.x, (int)gridDim.x);
    convert_ffn(p, 0, lds, (int)blockIdx.x, (int)gridDim.x);
    GRID_BAR();
    if (threadIdx.x == 0) {
        const unsigned* rw = (const unsigned*)(p.ws() + WS_BAR + 16384); const unsigned G = gridDim.x; bool ok = (G % 8u) == 0u;
        for (int jx = 0; jx < 8; ++jx) ok = ok && (__hip_atomic_load(rw + 64 * jx, __ATOMIC_RELAXED, __HIP_MEMORY_SCOPE_AGENT) == G / 8u);
        const int pk = *(volatile LAS int*)(lds + VCU_OFF); const int r = pk >> 4, x = pk & 15;
        *(volatile LAS int*)(lds + VCU_OFF) = (ok && x < 8) ? (r * 8 + x) : (int)blockIdx.x;
    }
    __syncthreads();
    phase_adaln_reduce(p);
    GRID_BAR();
    if (gridDim.x == 0x7fffffffu) grid.sync();
#pragma unroll 1
    for (int l = 0; l < 4; ++l) {
#pragma unroll 1
        for (int st = 0; st < 10; ++st) {
            const int kind = l % 3, j = l / 3;
            const bool isg = (st == 1) || (st == 2 && kind != 0) || st == 6 || st == 8 || st == 9;
            const bool did = !((st == 2 && kind == 0) || (st == 4 && kind != 1) || (st == 5 && kind != 1) || (st == 1 && kind != 0));
            if (isg) {
                if (threadIdx.x == 0) {
                    volatile LAS EpiD* e = (volatile LAS EpiD*)(lds + DESC_OFF);
                    unsigned char* ws = p.ws();
                    float* mods = (float*)(ws + WS_MODS); float* XC = (float*)(ws + WS_XC);
                    bf16* HX = (bf16*)(ws + WS_HX); bf16* WM = (bf16*)(ws + WS_WM); bf16* WF = (bf16*)(ws + WS_WF);
                    float* outp = p.out();
                    e->baseL = (l == 0) ? p.in(0) : outp; e->baseC = XC; e->outL = outp; e->outC = XC;
                    e->gateL = mods + (size_t)(l * 2 + 0) * 6144 + 2048; e->gateC = mods + (size_t)(l * 2 + 1) * 6144 + 2048;
                    e->ldc = 1024; e->part = (float*)(ws + WS_R + ((st == 9) ? 100 * MiB : 0));
                    if (st == 1) {
                        e->A = HX; e->Bt = WM; e->M = (l == 3) ? T_ : MT_; e->K = 1024;
                        if (kind == 0) { e->mode = EM_GLU; e->o0 = (bf16*)(ws + WS_Y1); e->bias = p.in(9) + j * 2048; e->N = 2048; }
                        else if (kind == 1) { e->mode = EM_RET; e->o0 = (bf16*)(ws + WS_RQ); e->o1 = (bf16*)(ws + WS_RG); e->o2 = (bf16*)(ws + WS_RK); e->N = 4096; }
                        else { e->mode = EM_ATT; e->o0 = (bf16*)(ws + WS_AQ); e->o1 = (bf16*)(ws + WS_AK); e->gq = p.in(19) + j * 64; e->gk = p.in(20) + j * 64; e->N = 1280; }
                    } else if (st == 2) {
                        e->Bt = HX; e->N = MT_; e->K = 1024;
                        if (kind == 1) { e->mode = EM_RETT; e->o0 = (bf16*)(ws + WS_RKT); e->o1 = (bf16*)(ws + WS_RVT); e->A = WM + (size_t)3072 * 1024; e->M = 3072; }
                        else { e->mode = EM_PLAIN; e->o0 = (bf16*)(ws + WS_AVT); e->ldc = 256; e->A = WM + (size_t)1280 * 1024; e->M = 256; }
                    } else if (st == 6) {
                        e->mode = EM_RES; e->M = (l >= 2) ? T_ : MT_; e->N = 1024;
                        if (kind == 0) { e->A = (const bf16*)(ws + WS_Y2); e->Bt = WM + 4 * MiB / 2; e->K = 1024; }
                        else if (kind == 1) { e->A = (const bf16*)(ws + WS_RG); e->Bt = WM + 12 * MiB / 2; e->K = 2048; }
                        else { e->A = (const bf16*)(ws + WS_AO); e->Bt = WM + 4 * MiB / 2; e->K = 1024; }
                    } else if (st == 8) { e->mode = EM_SWIGLU; e->o0 = (bf16*)(ws + WS_H); e->ldc = F_; e->A = HX; e->Bt = WF; e->M = (l >= 2) ? T_ : MT_; e->N = 2 * F_; e->K = 1024; }
                    else { e->mode = EM_RES; e->A = (const bf16*)(ws + WS_H); e->Bt = WF + 11 * MiB / 2; e->M = (l >= 2) ? T_ : MT_; e->N = 1024; e->K = F_;
                        e->baseL = outp; e->baseC = XC; e->gateL = mods + (size_t)(l * 2 + 0) * 6144 + 5120; e->gateC = mods + (size_t)(l * 2 + 1) * 6144 + 5120; }
                }
                __syncthreads();
                run_gemm(lds);
            } else if (st == 0) {
                float* XC = (float*)(p.ws() + WS_XC);
                phase_norm(p, l, false, (l == 0) ? p.in(0) : p.out(), XC, (const float*)(p.ws() + WS_R + 100 * MiB), (l == 0 || l == 3) ? 0 : 22); if (l > 0 && l != 1) convert_ffn(p, l, lds, (int)blockIdx.x, (int)gridDim.x);
            } else if (st == 7) {
                float* XC = (float*)(p.ws() + WS_XC);
                phase_norm(p, l, true, p.out(), XC, (const float*)(p.ws() + WS_R), (l >= 2) ? 0 : (kind == 1 ? 16 : 8)); if (l < 3 && l != 1) convert_mixer(p, l + 1, lds, (int)blockIdx.x, (int)gridDim.x);
            } else if (st == 3 || st == 4) {
                if (kind == 1) {
#ifndef NO_SCAN
                    ScanCtx sc; const int u = rfl_i(*(volatile LAS int*)(lds + VCU_OFF)); sc.active = u < 128; sc.h = u & 3; sc.dir = (u >> 2) & 1; sc.sl = (u >> 3) & 15;
                    sc.lg = log_sigmoid_f((sc.dir ? p.in(16) : p.in(15))[j * 4 + sc.h]);
                    scan_part(p, sc, st - 3, lds);
#endif
#ifndef NO_INTRA
                    if (st == 4 && u >= 128) phase_ret_intra(p, j, lds, 512, 520, u - 128, 128);
                    if (st == 3 && u >= 128) convert_ffn(p, l, lds, u - 128, (int)gridDim.x - 128);
                    if (st == 4 && u >= 136) { __syncthreads(); convert_mixer(p, l + 1, lds, u - 136, (int)gridDim.x - 136); }
#endif
                } else if (st == 3 && kind == 0) {
#ifndef NO_DW
                    phase_dwconv(p, j, (l == 3) ? T_ / 16 : MT_ / 16, lds);
#endif
                } else if (st == 3) {
#ifndef NO_ATTN
                    phase_attn(p, j, lds);
#endif
                }
            } else if (st == 5 && kind == 1) {
#ifndef NO_INTRA
                phase_ret_intra(p, j, lds, 0, 512, (int)blockIdx.x, (int)gridDim.x);
#endif
            }
            if (did) GRID_BAR();
        }
    }
}

extern "C" void kernel_launch(void* const* d_in, const int* in_sizes, int n_in, void* d_out, int out_size, void* d_ws, size_t ws_size, hipStream_t stream) {
    static int grid_blocks = 0;
    if (grid_blocks == 0) {
        if (n_in != 25 || ws_size < WS_END) { fprintf(stderr, "kernel_launch: unexpected n_in %d / ws_size %zu (need %zu)\n", n_in, ws_size, (size_t)WS_END); grid_blocks = -1; return; }
        int dev = 0, cus = 0, per_cu = 0;
        hipGetDevice(&dev);
        hipDeviceGetAttribute(&cus, hipDeviceAttributeMultiprocessorCount, dev);
        if (hipFuncSetAttribute((const void*)fwd_megakernel, hipFuncAttributeMaxDynamicSharedMemorySize, LDS_BYTES) != hipSuccess) { fprintf(stderr, "kernel_launch: hipFuncSetAttribute failed\n"); grid_blocks = -1; return; }
        hipOccupancyMaxActiveBlocksPerMultiprocessor(&per_cu, (const void*)fwd_megakernel, NTHREADS, LDS_BYTES);
        if (per_cu < 1) { fprintf(stderr, "kernel_launch: occupancy query gives %d\n", per_cu); per_cu = 1; }
        (void)hipGetLastError();
        grid_blocks = cus * 1;
        if (grid_blocks < 128) { fprintf(stderr, "kernel_launch: grid %d too small\n", grid_blocks); grid_blocks = -1; return; }
    }
    if (grid_blocks < 0) return;
    Params p{};
    for (int i = 0; i < 25; ++i) p.in[i] = (const float*)d_in[i];
    p.out = (float*)d_out; p.ws = (unsigned char*)d_ws;
    if (hipMemsetAsync((char*)d_ws + WS_BAR, 0, 32768, stream) != hipSuccess) { fprintf(stderr, "kernel_launch: memset failed\n"); return; }
    void* args[] = {&p};
    hipError_t e = hipLaunchCooperativeKernel((void*)fwd_megakernel, dim3(grid_blocks), dim3(NTHREADS), args, LDS_BYTES, stream);
    if (e != hipSuccess) fprintf(stderr, "cooperative launch failed: %s (grid %d)\n", hipGetErrorString(e), grid_blocks);
}
```

```cpp
#include <hip/hip_runtime.h>
#include <hip/hip_cooperative_groups.h>
#include <cstdio>
#include <cstdint>
namespace cg = cooperative_groups;
namespace pg8 {
#define PG8_LAS __attribute__((address_space(3)))
typedef unsigned short bf16_t;
typedef short bf16x8 __attribute__((ext_vector_type(8)));
typedef float f32x4 __attribute__((ext_vector_type(4)));
typedef unsigned u32x4 __attribute__((ext_vector_type(4)));
constexpr int BM = 256, BK = 64, HALF = 128, HTB = HALF * BK * 2  , STAGE_BYTES = 8 * HTB, NXCD = 8, WGM = 8;

__host__ __device__ __forceinline__ int lds_byte(int r, int c) { const int st = (r >> 4) * 2 + (c >> 5), rr = r & 15, cc = c & 31, ob = rr * 64 + cc * 2; return st * 1024 + (ob ^ (((ob >> 9) & 1) << 5)); }
__host__ __device__ __forceinline__ void stage_rc(int b, int& R, int& C) { const int st = b / 1024, sb = b % 1024, swz = sb ^ (((sb >> 9) & 1) << 5); R = (st >> 1) * 16 + swz / 64; C = (st & 1) * 32 + (swz % 64) / 2; }
__host__ __device__ __forceinline__ int perm32(int rho) { const int n = rho >> 4, i = rho & 15; return 8 * (i >> 2) + 4 * n + (i & 3); }

struct Unit { int pm, pn, kt0, ntu; };
struct Gemm { const bf16_t* A; const bf16_t* Bt; int M, N, K; };

struct StaticOrder {
    int nM, nN, nwg, G, c, ntK, nsplit;
    __host__ __device__ void init(int M, int N, int K, int G_, int c_, int split) { nM = M / BM; nN = N / BM; G = G_; c = c_; ntK = K / BK; nsplit = 0; if (split) { nM -= 1; nsplit = ntK / 2; } nwg = nM * nN; }
    __host__ __device__ __forceinline__ bool next(int i, Unit& u) const {
        const long L = (long)i * G + c;
        int pm, pn, kt0, ntu; bool ok;
        if (L >= nwg) { const int idx = (int)(L - nwg); ok = idx < nN * nsplit; pn = idx % nN; pm = nM; kt0 = 2 * (idx / nN); ntu = 2; }
        else {
            int wgid = (int)L; { const int q = nwg / NXCD, r = nwg % NXCD, xcd = wgid % NXCD, off = wgid / NXCD; wgid = (xcd < r ? xcd * (q + 1) : r * (q + 1) + (xcd - r) * q) + off; }
            const int nig = WGM * nN, gid = wgid / nig, fm = gid * WGM, gsz = (nM - fm) < WGM ? (nM - fm) : WGM;
            pm = fm + ((wgid % nig) % gsz); pn = (wgid % nig) / gsz; kt0 = 0; ntu = ntK; ok = true;
        }
        u.pm = pm; u.pn = pn; u.kt0 = kt0; u.ntu = ntu; return ok;
    }
    __device__ __forceinline__ void a_ready(const Unit&) const {}
    __device__ __forceinline__ void done(const Unit&) const {}
};

__device__ __forceinline__ unsigned cvt_pk_bf16(float lo, float hi) { unsigned r; asm volatile("v_cvt_pk_bf16_f32 %0, %1, %2" : "=v"(r) : "v"(lo), "v"(hi)); return r; }
template <class Epi, class Sched, bool ALIGN_EPI = false, bool SP2 = false>
__device__ __forceinline__ void gemm_phase(PG8_LAS unsigned char* lds, const Gemm g, const Sched& S, const Epi& E) {
    int tid_o = threadIdx.x; asm volatile("" : "+v"(tid_o));
    const int tid = tid_o, wid = __builtin_amdgcn_readfirstlane(tid >> 6), lane = tid & 63, wr = wid >> 2, wc = wid & 3, fr = lane & 15, fq = lane >> 4;
    const int K = g.K, nt = K / BK;
    unsigned voffA[2], voffB[2];
#pragma unroll
    for (int i = 0; i < 2; ++i) { int R, C; stage_rc(tid * 16 + i * 8192, R, C); const int Rb = Epi::PERM ? ((R & ~31) + perm32(R & 31)) : R;
        voffA[i] = (unsigned)(R * K + C) * 2u; voffB[i] = (unsigned)(Rb * K + C) * 2u; }
    const size_t kstep = (size_t)(BK * 2);
    const size_t hstep = (size_t)HALF * K * 2;
    const size_t tstep = 2 * hstep;
    const unsigned ldsw = (unsigned)wid * 1024u;
    const int aoff = lds_byte(wr * 64 + fr, fq * 8), boff = lds_byte(wc * 32 + fr, fq * 8);
#define PG8_SA(b, h) (((b) * 2 + (h)) * HTB)
#define PG8_SB(b, h) ((4 + (b) * 2 + (h)) * HTB)
#define PG8_STAGE(bufoff, gbase, voff) do { _Pragma("unroll") for (int _i = 0; _i < 2; ++_i) \
        __builtin_amdgcn_global_load_lds((const unsigned*)((const char*)(gbase) + (voff)[_i]), (PG8_LAS unsigned*)(lds + (bufoff) + ldsw + _i * 8192), 16, 0, 0); } while (0)
#define PG8_LDA(dst, b, h) do { _Pragma("unroll") for (int m = 0; m < 4; ++m) _Pragma("unroll") for (int k = 0; k < 2; ++k) dst[m][k] = *(const PG8_LAS bf16x8*)(lds + PG8_SA(b, h) + aoff + m * 2048 + k * 1024); } while (0)
#define PG8_LDB(dst, b, h) do { _Pragma("unroll") for (int n = 0; n < 2; ++n) _Pragma("unroll") for (int k = 0; k < 2; ++k) dst[n][k] = *(const PG8_LAS bf16x8*)(lds + PG8_SB(b, h) + boff + n * 2048 + k * 1024); } while (0)
#define PG8_MMA(ai, bj, At, Bt) do { __builtin_amdgcn_s_setprio(1); _Pragma("unroll") for (int m = 0; m < 4; ++m) _Pragma("unroll") for (int n = 0; n < 2; ++n) _Pragma("unroll") for (int k = 0; k < 2; ++k) \
        acc[ai][bj][m][n] = __builtin_amdgcn_mfma_f32_16x16x32_bf16(Bt[n][k], At[m][k], acc[ai][bj][m][n], 0, 0, 0); __builtin_amdgcn_s_setprio(0); } while (0)
#define PG8_WAIT_V(n) asm volatile("s_waitcnt vmcnt(" #n ")" ::: "memory")
#define PG8_WAIT_L(n) asm volatile("s_waitcnt lgkmcnt(" #n ")" ::: "memory")
#define PG8_BAR __builtin_amdgcn_s_barrier()
#define PG8_SCHED __builtin_amdgcn_sched_barrier(0)
    Unit cur, nxt; int ui = 0;
    if (!S.next(0, cur)) return;
    f32x4 acc[2][2][4][2];
#pragma unroll
    for (int a = 0; a < 2; ++a)
#pragma unroll
        for (int b = 0; b < 2; ++b)
#pragma unroll
            for (int m = 0; m < 4; ++m)
#pragma unroll
                for (int n = 0; n < 2; ++n) acc[a][b][m][n] = (f32x4){0.f, 0.f, 0.f, 0.f};
    bf16x8 At[4][2], B0[2][2], B1[2][2];
    const char* cA = (const char*)g.A + (size_t)cur.pm * tstep + (size_t)cur.kt0 * kstep; const char* cB = (const char*)g.Bt + (size_t)cur.pn * tstep + (size_t)cur.kt0 * kstep;
    S.a_ready(cur);
    if constexpr (SP2) {
        PG8_STAGE(PG8_SB(0, 0), cB, voffB); PG8_STAGE(PG8_SB(0, 1), cB + hstep, voffB); PG8_STAGE(PG8_SA(0, 0), cA, voffA); PG8_STAGE(PG8_SA(0, 1), cA + hstep, voffA);
        if (wr == 1) PG8_BAR;
        PG8_WAIT_V(2); PG8_BAR;
        PG8_STAGE(PG8_SB(1, 0), cB + kstep, voffB); PG8_STAGE(PG8_SA(1, 0), cA + kstep, voffA); PG8_STAGE(PG8_SB(1, 1), cB + hstep + kstep, voffB);
        PG8_WAIT_V(6); PG8_BAR;
    } else {
        PG8_STAGE(PG8_SB(0, 0), cB, voffB); PG8_STAGE(PG8_SA(0, 0), cA, voffA); PG8_STAGE(PG8_SB(0, 1), cB + hstep, voffB); PG8_STAGE(PG8_SA(0, 1), cA + hstep, voffA);
        if (wr == 1) PG8_BAR;
        PG8_WAIT_V(4); PG8_BAR;
        PG8_STAGE(PG8_SB(1, 0), cB + kstep, voffB); PG8_STAGE(PG8_SA(1, 0), cA + kstep, voffA); PG8_STAGE(PG8_SB(1, 1), cB + hstep + kstep, voffB);
        PG8_WAIT_V(6); PG8_BAR;
    }
    for (;;) {
        const bool has_next = S.next(ui + 1, nxt);
        const char* nA = has_next ? (const char*)g.A + (size_t)nxt.pm * tstep + (size_t)nxt.kt0 * kstep : cA; const char* nB = has_next ? (const char*)g.Bt + (size_t)nxt.pn * tstep + (size_t)nxt.kt0 * kstep : cB;
        const int ntc = cur.ntu;
        for (int t = 0; t < ntc; t += 2) {
            const bool last = (t == ntc - 2);
            const char* a1 = cA + (size_t)(t + 1) * kstep;
            const char* a2 = last ? nA : cA + (size_t)(t + 2) * kstep; const char* b2 = last ? nB : cB + (size_t)(t + 2) * kstep;
            const char* a3 = a2 + kstep; const char* b3 = b2 + kstep;
            if (last && has_next) S.a_ready(nxt);
            if constexpr (SP2) {
            PG8_LDB(B0, 0, 0); PG8_LDB(B1, 0, 1); PG8_SCHED; PG8_LDA(At, 0, 0); PG8_STAGE(PG8_SA(1, 1), a1 + hstep, voffA);
            PG8_WAIT_V(8); PG8_WAIT_L(0); PG8_BAR; PG8_MMA(0, 0, At, B0); PG8_MMA(0, 1, At, B1); PG8_BAR; PG8_SCHED;
            PG8_LDA(At, 0, 1); PG8_STAGE(PG8_SB(0, 0), b2, voffB); PG8_STAGE(PG8_SB(0, 1), b2 + hstep, voffB); PG8_STAGE(PG8_SA(0, 0), a2, voffA);
            PG8_WAIT_V(8); PG8_WAIT_L(0); PG8_BAR; PG8_MMA(1, 0, At, B0); PG8_MMA(1, 1, At, B1); PG8_BAR; PG8_SCHED;
            PG8_LDB(B0, 1, 0); PG8_LDB(B1, 1, 1); PG8_SCHED; PG8_LDA(At, 1, 0); PG8_STAGE(PG8_SA(0, 1), a2 + hstep, voffA);
            PG8_WAIT_V(8); PG8_WAIT_L(0); PG8_BAR; PG8_MMA(0, 0, At, B0); PG8_MMA(0, 1, At, B1); PG8_BAR; PG8_SCHED;
            PG8_LDA(At, 1, 1); PG8_STAGE(PG8_SB(1, 0), b3, voffB); PG8_STAGE(PG8_SB(1, 1), b3 + hstep, voffB); PG8_STAGE(PG8_SA(1, 0), a3, voffA);
            PG8_WAIT_V(8); PG8_WAIT_L(0); PG8_BAR; PG8_MMA(1, 0, At, B0); PG8_MMA(1, 1, At, B1); PG8_BAR; PG8_SCHED;
            } else {
            PG8_LDB(B0, 0, 0); PG8_SCHED; PG8_LDA(At, 0, 0); PG8_STAGE(PG8_SA(1, 1), a1 + hstep, voffA);
            PG8_WAIT_L(8); PG8_BAR; PG8_WAIT_L(0); PG8_MMA(0, 0, At, B0); PG8_BAR; PG8_SCHED;
            PG8_LDB(B1, 0, 1); PG8_STAGE(PG8_SB(0, 0), b2, voffB);
            PG8_BAR; PG8_WAIT_L(0); PG8_MMA(0, 1, At, B1); PG8_BAR;
            PG8_LDA(At, 0, 1); PG8_STAGE(PG8_SA(0, 0), a2, voffA);
            PG8_BAR; PG8_WAIT_L(0); PG8_MMA(1, 0, At, B0); PG8_BAR; PG8_SCHED;
            PG8_STAGE(PG8_SB(0, 1), b2 + hstep, voffB);
            PG8_WAIT_V(6); PG8_BAR; PG8_MMA(1, 1, At, B1); PG8_BAR;
            PG8_LDB(B0, 1, 0); PG8_SCHED; PG8_LDA(At, 1, 0); PG8_STAGE(PG8_SA(0, 1), a2 + hstep, voffA);
            PG8_WAIT_L(8); PG8_BAR; PG8_WAIT_L(0); PG8_MMA(0, 0, At, B0); PG8_BAR; PG8_SCHED;
            PG8_LDB(B1, 1, 1); PG8_STAGE(PG8_SB(1, 0), b3, voffB);
            PG8_BAR; PG8_WAIT_L(0); PG8_MMA(0, 1, At, B1); PG8_BAR;
            PG8_LDA(At, 1, 1); PG8_STAGE(PG8_SA(1, 0), a3, voffA);
            PG8_BAR; PG8_WAIT_L(0); PG8_MMA(1, 0, At, B0); PG8_BAR; PG8_SCHED;
            PG8_STAGE(PG8_SB(1, 1), b3 + hstep, voffB);
            PG8_WAIT_V(6); PG8_BAR; PG8_MMA(1, 1, At, B1); PG8_BAR;
            }
        }
        if constexpr (ALIGN_EPI) { if (wr == 0) PG8_BAR; }
        if constexpr (!Epi::AFTER_DRAIN) { E(acc, cur, wr, wc, fr, fq); S.done(cur); }
        if (!has_next) break;
#pragma unroll
        for (int a = 0; a < 2; ++a)
#pragma unroll
            for (int b = 0; b < 2; ++b)
#pragma unroll
                for (int m = 0; m < 4; ++m)
#pragma unroll
                    for (int n = 0; n < 2; ++n) acc[a][b][m][n] = (f32x4){0.f, 0.f, 0.f, 0.f};
        cur = nxt; cA = nA; cB = nB; ++ui;
        if constexpr (ALIGN_EPI) { if (wr == 1) PG8_BAR; }
    }
    PG8_WAIT_V(0);
    if constexpr (!ALIGN_EPI) { if (wr == 0) PG8_BAR; }
    PG8_BAR;
    if constexpr (Epi::AFTER_DRAIN) { E.fused(acc, cur, wr, wc, fr, fq, lds, wid, lane); S.done(cur); }
#undef PG8_SA
#undef PG8_SB
#undef PG8_STAGE
#undef PG8_LDA
#undef PG8_LDB
#undef PG8_MMA
#undef PG8_WAIT_V
#undef PG8_WAIT_L
#undef PG8_BAR
#undef PG8_SCHED
}
}

#define LAS __attribute__((address_space(3)))
typedef unsigned short bf16;
typedef short bf16x8 __attribute__((ext_vector_type(8)));
typedef float f32x4 __attribute__((ext_vector_type(4)));
typedef float f32x16 __attribute__((ext_vector_type(16)));
typedef unsigned u32x4 __attribute__((ext_vector_type(4)));
typedef unsigned u32x2 __attribute__((ext_vector_type(2)));
typedef float f32x2 __attribute__((ext_vector_type(2)));

constexpr int T_ = 16384, L_ = 256, MT_ = 16640, D_ = 1024, F_ = 2816;
constexpr int NTHREADS = 512, NWAVES = 8;
constexpr int LDS_BYTES = 131072 + 512;
constexpr int VCU_OFF = 131072 + 496;
constexpr int PARAM_OFF = 131072 + 256;
constexpr size_t MiB = 1u << 20;
constexpr size_t WS_MODS = 0, WS_XC = 1 * MiB, WS_WM = 2 * MiB, WS_WF = 18 * MiB, WS_HX = 35 * MiB, WS_R = 68 * MiB;
constexpr size_t WS_Y1 = WS_R, WS_Y2 = WS_R + 33 * MiB;
constexpr size_t WS_H = WS_R;
constexpr size_t WS_RQ = WS_R, WS_RK = WS_R + 33 * MiB, WS_RG = WS_R + 66 * MiB, WS_RKT = WS_R + 131 * MiB, WS_RVT = WS_R + 164 * MiB,
                 WS_ROI = WS_R + 229 * MiB, WS_ROIC = WS_R + 293 * MiB, WS_END = WS_R + 300 * MiB;
constexpr size_t WS_AQ = WS_R, WS_AK = WS_R + 33 * MiB, WS_AVT = WS_R + 42 * MiB, WS_AO = WS_R + 66 * MiB;
static_assert(WS_END <= 384 * MiB, "ws");
constexpr size_t WS_BAR = 512 * 1024;

struct Params { const float* in[25]; float* out; unsigned char* ws; };
__device__ __forceinline__ int rfl_i(int v) { return __builtin_amdgcn_readfirstlane(v); }
template <class P> __device__ __forceinline__ P rfl_p(P v) { const unsigned long long x = (unsigned long long)v; const unsigned lo = __builtin_amdgcn_readfirstlane((unsigned)x), hi = __builtin_amdgcn_readfirstlane((unsigned)(x >> 32)); return (P)(((unsigned long long)hi << 32) | lo); }
template <class T> __device__ __forceinline__ T* as_global(T* p) { return (T*)(__attribute__((address_space(1))) T*)(unsigned long long)p; }
struct LP {
    const LAS unsigned long long* q;
    __device__ __forceinline__ const float* in(int i) const { return as_global((const float*)rfl_p(q[i])); }
    __device__ __forceinline__ float* out() const { return as_global((float*)rfl_p(q[25])); }
    __device__ __forceinline__ unsigned char* ws() const { return as_global((unsigned char*)rfl_p(q[26])); }
};

__device__ __forceinline__ int otid() { int t = threadIdx.x; asm volatile("" : "+v"(t)); return t; }
__device__ __forceinline__ size_t tr_off(int row, int tok, int NR) { return ((size_t)(tok >> 7) * NR + row) * 128 + (tok & 127); }
__device__ __forceinline__ size_t kt_off(int row, int tok) { const int h = row >> 8, d = row & 255, t = tok & 127;
    return ((((size_t)(tok >> 7) * 4 + h) * 8 + (d >> 5)) * 8 + (t >> 4)) * 512 + ((((t >> 3) & 1) * 32 + (d & 31)) * 8) + (t & 7); }
__device__ __forceinline__ size_t q_off(int row, int h, int sd) { const int t = row & 127;
    return ((((size_t)(row >> 7) * 4 + h) * 8 + (t >> 4)) * 8 + (sd >> 5)) * 512 + ((((sd >> 3) & 3) * 16 + (t & 15)) * 8) + (sd & 7); }
__device__ __forceinline__ float bf2f(unsigned short u) { return __uint_as_float(((unsigned)u) << 16); }
typedef __bf16 bf16x2_t __attribute__((ext_vector_type(2)));
__device__ __forceinline__ unsigned pk2(float lo, float hi) { const f32x2 v = {lo, hi}; const bf16x2_t b = __builtin_convertvector(v, bf16x2_t); return __builtin_bit_cast(unsigned, b); }
__device__ __forceinline__ float silu_f(float x) { return x / (1.0f + __expf(-x)); }
__device__ __forceinline__ float sigmoid_f(float x) { return 1.0f / (1.0f + __expf(-x)); }
__device__ __forceinline__ void st4bf(bf16* p, f32x4 v) { u32x2 w; w.x = pk2(v[0], v[1]); w.y = pk2(v[2], v[3]); *(u32x2*)p = w; }
__device__ __forceinline__ float wave_sum(float v) {
#pragma unroll
    for (int o = 1; o < 64; o <<= 1) v += __shfl_xor(v, o);
    return v;
}

#ifndef EPI_MASK
#define EPI_MASK 0x7f
#endif
#define EPI_ON(m) ((EPI_MASK >> (m)) & 1)
enum { EM_GLU = 0, EM_SWIGLU = 1, EM_RES = 2, EM_RET = 3, EM_RETT = 4, EM_ATT = 5, EM_PLAIN = 6 };
struct EpiD {
    int mode, ldc, M, N, K, pad;
    const bf16* A; const bf16* Bt;
    bf16* o0; bf16* o1; bf16* o2;
    const float* bias; const float* baseL; const float* baseC; float* outL; float* outC;
    const float* gateL; const float* gateC; const float* gq; const float* gk;
    float* part;
};
constexpr int DESC_OFF = 131072;
struct Epi {
    static constexpr bool PERM = false, AFTER_DRAIN = false;
    const LAS EpiD* d;
    __device__ __forceinline__ void operator()(const f32x4 (&acc)[2][2][4][2], const pg8::Unit& u, int wr_, int wc_, int fr_, int fq_) const {
        const int mode = rfl_i(d->mode);
        using namespace pg8;
        int wr = wr_, wc = wc_, fr = fr_, fq = fq_;
        asm volatile("" : "+v"(fr), "+v"(fq)); asm volatile("" : "+s"(wr), "+s"(wc));
        const int rowb = u.pm * BM + wr * 64 + fr;
        const int colb = u.pn * BM + wc * 32 + 4 * fq;
        if ((EPI_ON(EM_GLU) && mode == EM_GLU) || (EPI_ON(EM_SWIGLU) && mode == EM_SWIGLU)) {
            const int ch = u.pn * 128 + wc * 32 + 4 * fq;
            bf16* const o0 = as_global(d->o0); const float* const bias = as_global(d->bias); const int ldc = d->ldc;
            f32x4 ba[2], bg[2];
#pragma unroll
            for (int n = 0; n < 2; ++n) {
                if (mode == EM_GLU) { ba[n] = *(const f32x4*)(bias + ch + 16 * n); bg[n] = *(const f32x4*)(bias + 1024 + ch + 16 * n); }
                else { ba[n] = (f32x4){0.f, 0.f, 0.f, 0.f}; bg[n] = ba[n]; }
            }
#pragma unroll
            for (int ai = 0; ai < 2; ++ai)
#pragma unroll
                for (int m = 0; m < 4; ++m) {
                    bf16* rp = o0 + (size_t)(rowb + ai * HALF + m * 16) * ldc + ch;
#pragma unroll
                    for (int n = 0; n < 2; ++n) {
                        const f32x4 a = acc[ai][0][m][n] + ba[n], g = acc[ai][1][m][n] + bg[n];
                        f32x4 v;
                        if (mode == EM_GLU) { v[0] = a[0] * sigmoid_f(g[0]); v[1] = a[1] * sigmoid_f(g[1]); v[2] = a[2] * sigmoid_f(g[2]); v[3] = a[3] * sigmoid_f(g[3]); }
                        else { v[0] = silu_f(a[0]) * g[0]; v[1] = silu_f(a[1]) * g[1]; v[2] = silu_f(a[2]) * g[2]; v[3] = silu_f(a[3]) * g[3]; }
                        st4bf(rp + 16 * n, v);
                    }
                }
        } else if (EPI_ON(EM_RES) && mode == EM_RES) {
            const bool isc = (u.pm >= T_ / BM);
            const float* gt = isc ? as_global(d->gateC) : as_global(d->gateL);
            f32x4 gv[2][2];
#pragma unroll
            for (int bj = 0; bj < 2; ++bj)
#pragma unroll
                for (int n = 0; n < 2; ++n) gv[bj][n] = *(const f32x4*)(gt + colb + bj * HALF + 16 * n);
            const float* bs = isc ? as_global(d->baseC) : as_global(d->baseL); float* ot = isc ? as_global(d->outC) : as_global(d->outL);
            const int rsub = isc ? T_ : 0;
#pragma unroll
            for (int ai = 0; ai < 2; ++ai)
#pragma unroll
                for (int m = 0; m < 4; ++m) {
                    const size_t off = (size_t)(rowb + ai * HALF + m * 16 - rsub) * D_ + colb;
#pragma unroll
                    for (int bj = 0; bj < 2; ++bj)
#pragma unroll
                        for (int n = 0; n < 2; ++n) {
                            if (isc) {
                                *(f32x4*)(as_global(d->part) + (size_t)(u.kt0 >> 1) * (L_ * D_) + off + bj * HALF + 16 * n) = gv[bj][n] * acc[ai][bj][m][n];
                            } else {
                                const f32x4 b = *(const f32x4*)(bs + off + bj * HALF + 16 * n);
                                *(f32x4*)(ot + off + bj * HALF + 16 * n) = b + gv[bj][n] * acc[ai][bj][m][n];
                            }
                        }
                }
        } else if (EPI_ON(EM_RET) && mode == EM_RET) {
            bf16* const o0 = as_global(d->o0); bf16* const o1 = as_global(d->o1); bf16* const o2 = as_global(d->o2);
            if (u.pn >= 4 && u.pn < 12) {
                const int cg0 = (u.pn - 4) * BM + wc * 32 + 4 * fq;
#pragma unroll
                for (int ai = 0; ai < 2; ++ai)
#pragma unroll
                    for (int m = 0; m < 4; ++m) {
                        bf16* rp = o1 + (size_t)(rowb + ai * HALF + m * 16) * 2048 + cg0;
#pragma unroll
                        for (int bj = 0; bj < 2; ++bj)
#pragma unroll
                            for (int n = 0; n < 2; ++n) { const f32x4 a = acc[ai][bj][m][n]; f32x4 v; v[0] = silu_f(a[0]); v[1] = silu_f(a[1]); v[2] = silu_f(a[2]); v[3] = silu_f(a[3]); st4bf(rp + bj * HALF + 16 * n, v); }
                    }
            } else {
                const bool isk = u.pn >= 12; const int h = u.pn & 3; bf16* ob = isk ? o2 : o0; const float sc = isk ? 0.0625f : 1.0f;
                float inv[2][4];
#pragma unroll
                for (int n = 0; n < 2; ++n)
#pragma unroll
                    for (int e = 0; e < 4; ++e) { const int i = 32 * (wc & 1) + 16 * n + 4 * fq + e; inv[n][e] = exp2f(-(float)i * (13.287712379549449f / 64.0f)); }
                const int j0 = wc * 32 + 4 * fq;
#pragma unroll
                for (int ai = 0; ai < 2; ++ai)
#pragma unroll
                    for (int m = 0; m < 4; ++m) {
                        const int row = rowb + ai * HALF + m * 16;
                        const bool lat = row < T_;
                        const float pos = (float)((wc < 2) ? (row >> 6) : (row & 63));
                        bf16* rp = ob + (size_t)row * 1024 + 256 * h + j0;
#pragma unroll
                        for (int n = 0; n < 2; ++n) {
                            const f32x4 x1 = acc[ai][0][m][n], x2 = acc[ai][1][m][n]; f32x4 r1, r2;
#pragma unroll
                            for (int e = 0; e < 4; ++e) {
                                const float ang = pos * inv[n][e]; float c = __cosf(ang), s = __sinf(ang);
                                if (!lat) { c = 1.f; s = 0.f; }
                                r1[e] = (x1[e] * c - x2[e] * s) * sc; r2[e] = (x2[e] * c + x1[e] * s) * sc;
                            }
                            if (isk) { st4bf(rp + 16 * n, r1); st4bf(rp + 128 + 16 * n, r2); }
                            else { st4bf(ob + q_off(row, h, j0 + 16 * n), r1); st4bf(ob + q_off(row, h, j0 + 16 * n + 128), r2); }
                        }
                    }
            }
        } else if (EPI_ON(EM_RETT) && mode == EM_RETT) {
            bf16* const o0 = as_global(d->o0); bf16* const o1 = as_global(d->o1);
            if (u.pm >= 4) {
#pragma unroll
                for (int ai = 0; ai < 2; ++ai)
#pragma unroll
                    for (int m = 0; m < 4; ++m) {
                        const int vrow = rowb - 4 * BM + ai * HALF + m * 16;
#pragma unroll
                        for (int bj = 0; bj < 2; ++bj)
#pragma unroll
                            for (int n = 0; n < 2; ++n) st4bf(o1 + tr_off(vrow, colb + bj * HALF + 16 * n, 2048), acc[ai][bj][m][n]);
                    }
            } else {
                float inv[4];
#pragma unroll
                for (int m = 0; m < 4; ++m) { const int i = 16 * m + fr; inv[m] = exp2f(-(float)i * (13.287712379549449f / 64.0f)); }
#pragma unroll
                for (int bj = 0; bj < 2; ++bj)
#pragma unroll
                    for (int n = 0; n < 2; ++n) {
                        const int tok0 = colb + bj * HALF + 16 * n;
                        const bool lat = tok0 < T_;
#pragma unroll
                        for (int m = 0; m < 4; ++m) {
                            const f32x4 x1 = acc[0][bj][m][n], x2 = acc[1][bj][m][n]; f32x4 r1, r2;
#pragma unroll
                            for (int e = 0; e < 4; ++e) {
                                const int tok = tok0 + e;
                                const float pos = (float)((wr == 0) ? (tok >> 6) : (tok & 63));
                                const float ang = pos * inv[m]; float c = __cosf(ang), s = __sinf(ang);
                                if (!lat) { c = 1.f; s = 0.f; }
                                r1[e] = (x1[e] * c - x2[e] * s) * 0.0625f; r2[e] = (x2[e] * c + x1[e] * s) * 0.0625f;
                            }
                            const int row = u.pm * BM + wr * 64 + m * 16 + fr;
                            st4bf(o0 + kt_off(row, tok0), r1); st4bf(o0 + kt_off(row + 128, tok0), r2);
                        }
                    }
            }
        } else if (EPI_ON(EM_ATT) && mode == EM_ATT) {
            bf16* const o0 = as_global(d->o0); bf16* const o1 = as_global(d->o1);
            const bool isk = u.pn >= 4; const float* gn = isk ? as_global(d->gk) : as_global(d->gq);
            f32x4 gv[2][2];
#pragma unroll
            for (int bj = 0; bj < 2; ++bj)
#pragma unroll
                for (int n = 0; n < 2; ++n) gv[bj][n] = *(const f32x4*)(gn + 32 * n + 16 * bj + 4 * fq);
            float inv[4];
#pragma unroll
            for (int e = 0; e < 4; ++e) { const int i = 4 * fq + e; inv[e] = exp2f(-(float)i * (13.287712379549449f / 16.0f)); }
            const float sc = isk ? 1.0f : 0.125f;
            bf16* ob = isk ? o1 : o0; const int ld = isk ? 256 : 1024;
            const int cb = (isk ? 0 : u.pn * BM) + 64 * wc + 4 * fq;
#pragma unroll
            for (int ai = 0; ai < 2; ++ai)
#pragma unroll
                for (int m = 0; m < 4; ++m) {
                    const int row = rowb + ai * HALF + m * 16;
                    const bool lat = row < T_;
                    float ss = 0.f;
#pragma unroll
                    for (int bj = 0; bj < 2; ++bj)
#pragma unroll
                        for (int n = 0; n < 2; ++n) { const f32x4 a = acc[ai][bj][m][n]; ss += (a[0] * a[0] + a[1] * a[1]) + (a[2] * a[2] + a[3] * a[3]); }
                    ss += __shfl_xor(ss, 16); ss += __shfl_xor(ss, 32);
                    const float rstd = rsqrtf(ss * (1.0f / 64.0f) + 1e-6f);
                    bf16* rp = ob + (size_t)row * ld + cb;
#pragma unroll
                    for (int n = 0; n < 2; ++n) {
                        const float pos = (float)((n == 0) ? (row >> 6) : (row & 63));
                        const f32x4 y1 = acc[ai][0][m][n] * rstd * gv[0][n], y2 = acc[ai][1][m][n] * rstd * gv[1][n]; f32x4 r1, r2;
#pragma unroll
                        for (int e = 0; e < 4; ++e) {
                            const float ang = pos * inv[e]; float c = __cosf(ang), s = __sinf(ang);
                            if (!lat) { c = 1.f; s = 0.f; }
                            r1[e] = (y1[e] * c - y2[e] * s) * sc; r2[e] = (y2[e] * c + y1[e] * s) * sc;
                        }
                        st4bf(rp + 16 * n, r1); st4bf(rp + 32 + 16 * n, r2);
                    }
                }
        } else if (EPI_ON(EM_PLAIN)) {
            bf16* const o0 = as_global(d->o0); const int ldc = d->ldc;
#pragma unroll
            for (int ai = 0; ai < 2; ++ai)
#pragma unroll
                for (int m = 0; m < 4; ++m) {
                    const int vrow = rowb + ai * HALF + m * 16;
#pragma unroll
                    for (int bj = 0; bj < 2; ++bj)
#pragma unroll
                        for (int n = 0; n < 2; ++n) st4bf(o0 + tr_off(vrow, colb + bj * HALF + 16 * n, ldc), acc[ai][bj][m][n]);
                }
        }
    }
};

__device__ __forceinline__ void run_gemm(LAS unsigned char* lds) {
    const LAS EpiD* d = (const LAS EpiD*)(lds + DESC_OFF);
    const int M = rfl_i(d->M), N = rfl_i(d->N), K = rfl_i(d->K);
    pg8::Gemm g{as_global(rfl_p(d->A)), as_global(rfl_p(d->Bt)), M, N, K}; pg8::StaticOrder S; const int md = rfl_i(d->mode); const int G = (int)gridDim.x;
    const int vcu = rfl_i(*(volatile LAS int*)(lds + VCU_OFF));
    const int cb = (md == EM_RETT || md == EM_PLAIN) ? (int)(((unsigned)vcu + (unsigned)G / 2u) % (unsigned)G) : vcu;
    S.init(M, N, K, G, cb, (md == EM_RES && M == MT_) ? 1 : 0);
    Epi E; E.d = d;
#ifndef NO_GEMM
    pg8::gemm_phase<Epi, pg8::StaticOrder, true, true>(lds, g, S, E);
#endif
    __syncthreads();
}

__device__ __forceinline__ int dest_row(int kind, int n, int N) {
    if (kind == 1) { const int half = N >> 1; if (n < half) return ((n >> 7) << 8) + (n & 127); const int q = n - half; return ((q >> 7) << 8) + 128 + (q & 127); }
    if (kind == 2) {
        if (n < 2048) { const int isk = n >> 10, hn = n & 1023, h = hn >> 8, d = hn & 255, bj = (d >> 6) & 1, j = (d & 63) + ((d >> 7) << 6); return (isk ? 3072 : 0) + 256 * h + 128 * bj + j; }
        if (n < 4096) return 4096 + (n - 2048);
        return 1024 + (n - 4096);
    }
    if (kind == 3) {
        if (n < 1280) { const int isk = n >= 1024; const int hn = isk ? n - 1024 : n; const int head = hn >> 6, d = hn & 63, bj = (d >> 4) & 1, nn = d >> 5, jj = d & 15;
            const int pn = isk ? 4 : (head >> 2), wc = head & 3; return 256 * pn + 128 * bj + 32 * wc + 16 * nn + jj; }
        return n;
    }
    return n;
}
__device__ __forceinline__ void convert_matrix(const float* W, int K, int N, bf16* WT, int kind, LAS float* scr, int gw, int NGW, int lane) {
    const int nblk = N / 32, nitems = (K / 64) * nblk;
    for (int item = gw; item < nitems; item += NGW) {
        const int kb = item / nblk, nb = item % nblk, k0 = 64 * kb, n0 = 32 * nb;
        float wreg[32];
#pragma unroll
        for (int i = 0; i < 32; ++i) { const int kk = 2 * i + (lane >> 5); wreg[i] = __builtin_nontemporal_load(W + (size_t)(k0 + kk) * N + n0 + (lane & 31)); }
        __builtin_amdgcn_sched_barrier(0);
#pragma unroll
        for (int i = 0; i < 32; ++i) { const int kk = 2 * i + (lane >> 5); scr[kk * 33 + (lane & 31)] = wreg[i]; }
        asm volatile("s_waitcnt lgkmcnt(0)" ::: "memory");
        const int c = lane & 7;
#pragma unroll
        for (int j = 0; j < 4; ++j) { const int n = (lane >> 3) + 8 * j; const LAS float* s = scr + (8 * c) * 33 + n;
            u32x4 o; o.x = pk2(s[0 * 33], s[1 * 33]); o.y = pk2(s[2 * 33], s[3 * 33]); o.z = pk2(s[4 * 33], s[5 * 33]); o.w = pk2(s[6 * 33], s[7 * 33]);
            *(u32x4*)(WT + (size_t)dest_row(kind, n0 + n, N) * K + k0 + 8 * c) = o; }
        asm volatile("s_waitcnt lgkmcnt(0)" ::: "memory");
    }
}
__device__ __forceinline__ void convert_mixer(const LP& p, int l, LAS unsigned char* lds, int bidx, int nblk) {
    const int tid = otid(), lane = tid & 63, wave = tid >> 6; const int gw = bidx * NWAVES + wave, NGW = nblk * NWAVES;
    LAS float* scr = (LAS float*)(lds + wave * 8704);
    bf16* wm = (bf16*)(p.ws() + WS_WM);
    const int kind = l % 3, j = l / 3;
    if (kind == 0) {
        convert_matrix(p.in(8) + (size_t)j * 1024 * 2048, 1024, 2048, wm, 1, scr, gw, NGW, lane);
        convert_matrix(p.in(13) + (size_t)j * 1024 * 1024, 1024, 1024, wm + 4 * MiB / 2, 0, scr, gw, NGW, lane);
    } else if (kind == 1) {
        convert_matrix(p.in(14) + (size_t)j * 1024 * 6144, 1024, 6144, wm, 2, scr, gw, NGW, lane);
        convert_matrix(p.in(17) + (size_t)j * 2048 * 1024, 2048, 1024, wm + 12 * MiB / 2, 0, scr, gw, NGW, lane);
    } else {
        convert_matrix(p.in(18) + (size_t)j * 1024 * 1536, 1024, 1536, wm, 3, scr, gw, NGW, lane);
        convert_matrix(p.in(22) + (size_t)j * 1024 * 1024, 1024, 1024, wm + 4 * MiB / 2, 0, scr, gw, NGW, lane);
    }
}
__device__ __forceinline__ void convert_ffn(const LP& p, int l, LAS unsigned char* lds, int bidx, int nblk) {
    const int tid = otid(), lane = tid & 63, wave = tid >> 6; const int gw = bidx * NWAVES + wave, NGW = nblk * NWAVES;
    LAS float* scr = (LAS float*)(lds + wave * 8704);
    bf16* wf = (bf16*)(p.ws() + WS_WF);
    convert_matrix(p.in(23) + (size_t)l * 1024 * 5632, 1024, 5632, wf, 1, scr, gw, NGW, lane);
    convert_matrix(p.in(24) + (size_t)l * 2816 * 1024, 2816, 1024, wf + 11 * MiB / 2, 0, scr, gw, NGW, lane);
}

constexpr size_t WS_ADAP = WS_R;
__device__ __forceinline__ void phase_adaln_partial(const LP& p) {
    const int tid = otid();
    float* part = (float*)(p.ws() + WS_ADAP);
    const float* c = p.in(1); const float* cc = p.in(3);
    for (int u = blockIdx.x; u < 256; u += gridDim.x) {
        const int l = u >> 6, k0 = (u & 63) * 16;
        const float* W = p.in(4) + (size_t)l * 1024 * 6144 + (size_t)k0 * 6144;
        f32x4 a0[3], a1[3];
#pragma unroll
        for (int q = 0; q < 3; ++q) { a0[q] = (f32x4){0.f, 0.f, 0.f, 0.f}; a1[q] = a0[q]; }
#pragma unroll
        for (int hb = 0; hb < 2; ++hb) {
            f32x4 wb[8][3]; float s0[8], s1[8];
#pragma unroll
            for (int kk = 0; kk < 8; ++kk) {
#pragma unroll
                for (int q = 0; q < 3; ++q) wb[kk][q] = __builtin_nontemporal_load((const f32x4*)(W + (size_t)(8 * hb + kk) * 6144 + 4 * tid + 2048 * q));
                s0[kk] = c[k0 + 8 * hb + kk]; s1[kk] = cc[k0 + 8 * hb + kk];
            }
            __builtin_amdgcn_sched_barrier(0);
#pragma unroll
            for (int kk = 0; kk < 8; ++kk) {
                const float t0 = silu_f(s0[kk]), t1 = silu_f(s1[kk]);
#pragma unroll
                for (int q = 0; q < 3; ++q) { a0[q] += wb[kk][q] * t0; a1[q] += wb[kk][q] * t1; }
            }
        }
#pragma unroll
        for (int q = 0; q < 3; ++q) { *(f32x4*)(part + (size_t)(u * 2 + 0) * 6144 + 4 * tid + 2048 * q) = a0[q]; *(f32x4*)(part + (size_t)(u * 2 + 1) * 6144 + 4 * tid + 2048 * q) = a1[q]; }
    }
}
__device__ __forceinline__ void phase_adaln_reduce(const LP& p) {
    const int tid = otid();
    const float* part = (const float*)(p.ws() + WS_ADAP); float* mods = (float*)(p.ws() + WS_MODS);
    for (int i = blockIdx.x * NTHREADS + tid; i < 4 * 2 * 6144 / 4; i += gridDim.x * NTHREADS) {
        const int l = i / (2 * 1536), r = i % (2 * 1536), sidx = r / 1536, c4 = r % 1536;
        f32x4 acc = *(const f32x4*)(p.in(5) + l * 6144 + 4 * c4);
#pragma unroll 8
        for (int kc = 0; kc < 64; ++kc) acc += *(const f32x4*)(part + (size_t)((l * 64 + kc) * 2 + sidx) * 6144 + 4 * c4);
        *(f32x4*)(mods + (size_t)(l * 2 + sidx) * 6144 + 4 * c4) = acc;
    }
}

__device__ __forceinline__ void phase_norm(const LP& p, int l, bool ffn, const float* xl, float* xc, const float* part, int nparts) {
    const int tid = otid(), lane = tid & 63, wave = tid >> 6; const int gw = blockIdx.x * NWAVES + wave, NGW = gridDim.x * NWAVES;
    const float* mods = (const float*)(p.ws() + WS_MODS);
    const float* g = (ffn ? p.in(7) : p.in(6)) + l * 1024;
    bf16* HX = (bf16*)(p.ws() + WS_HX);
    f32x4 gv[4];
#pragma unroll
    for (int j = 0; j < 4; ++j) gv[j] = *(const f32x4*)(g + 4 * lane + 256 * j);
    {
        const float* mb = mods + (size_t)(l * 2) * 6144 + (ffn ? 3072 : 0);
        f32x4 sh[4], sc[4], vn[4];
#pragma unroll
        for (int j = 0; j < 4; ++j) { sh[j] = *(const f32x4*)(mb + 4 * lane + 256 * j); sc[j] = *(const f32x4*)(mb + 1024 + 4 * lane + 256 * j) + 1.0f; }
        int m = gw;
        if (m < T_) {
#pragma unroll
            for (int j = 0; j < 4; ++j) vn[j] = *(const f32x4*)(xl + (size_t)m * 1024 + 4 * lane + 256 * j);
        }
        for (; m < T_; m += NGW) {
            f32x4 v[4]; float s = 0.f;
#pragma unroll
            for (int j = 0; j < 4; ++j) v[j] = vn[j];
            const int mn = m + NGW;
            if (mn < T_) {
#pragma unroll
                for (int j = 0; j < 4; ++j) vn[j] = *(const f32x4*)(xl + (size_t)mn * 1024 + 4 * lane + 256 * j);
            }
#pragma unroll
            for (int j = 0; j < 4; ++j) s += (v[j][0] * v[j][0] + v[j][1] * v[j][1]) + (v[j][2] * v[j][2] + v[j][3] * v[j][3]);
            const float rstd = rsqrtf(wave_sum(s) * (1.0f / 1024.0f) + 1e-6f);
#pragma unroll
            for (int j = 0; j < 4; ++j) st4bf(HX + (size_t)m * 1024 + 4 * lane + 256 * j, v[j] * rstd * gv[j] * sc[j] + sh[j]);
        }
    }
    for (int m = T_ + gw; m < MT_; m += NGW) {
        float* xr = xc + (size_t)(m - T_) * 1024;
        const float* mb = mods + (size_t)(l * 2 + 1) * 6144 + (ffn ? 3072 : 0);
        f32x4 v[4]; float s = 0.f;
#pragma unroll
        for (int j = 0; j < 4; ++j) v[j] = *(const f32x4*)(xr + 4 * lane + 256 * j);
        if (nparts > 0) {
            for (int sp0 = 0; sp0 < nparts; sp0 += 4) {
                f32x4 pb[4][4];
#pragma unroll
                for (int q = 0; q < 4; ++q) { const int sp = (sp0 + q < nparts) ? sp0 + q : sp0;
#pragma unroll
                    for (int j = 0; j < 4; ++j) pb[q][j] = *(const f32x4*)(part + (size_t)sp * (L_ * D_) + (size_t)(m - T_) * 1024 + 4 * lane + 256 * j); }
                __builtin_amdgcn_sched_barrier(0);
#pragma unroll
                for (int q = 0; q < 4; ++q) { if (sp0 + q < nparts) {
#pragma unroll
                    for (int j = 0; j < 4; ++j) v[j] += pb[q][j]; } }
            }
#pragma unroll
            for (int j = 0; j < 4; ++j) *(f32x4*)(xr + 4 * lane + 256 * j) = v[j];
        }
#pragma unroll
        for (int j = 0; j < 4; ++j) s += (v[j][0] * v[j][0] + v[j][1] * v[j][1]) + (v[j][2] * v[j][2] + v[j][3] * v[j][3]);
        const float rstd = rsqrtf(wave_sum(s) * (1.0f / 1024.0f) + 1e-6f);
#pragma unroll
        for (int j = 0; j < 4; ++j) {
            const f32x4 sh = *(const f32x4*)(mb + 4 * lane + 256 * j), sc = *(const f32x4*)(mb + 1024 + 4 * lane + 256 * j);
            st4bf(HX + (size_t)m * 1024 + 4 * lane + 256 * j, v[j] * rstd * gv[j] * (sc + 1.0f) + sh);
        }
    }
}

__device__ __forceinline__ void phase_dwconv(const LP& p, int j, int nunits, LAS unsigned char* lds) {
    const int tid = otid(), lane = tid & 63, wave = tid >> 6;
    const bf16* Y1 = (const bf16*)(p.ws() + WS_Y1); bf16* Y2 = (bf16*)(p.ws() + WS_Y2);
    const float* dw = p.in(10) + (size_t)j * 31 * 1024; const float* dwb = p.in(11) + j * 1024; const float* ng = p.in(12) + j * 1024;
    LAS float* tile = (LAS float*)lds;
    f32x2 wv[31];
#pragma unroll
    for (int w = 0; w < 31; ++w) wv[w] = *(const f32x2*)(dw + w * 1024 + 2 * tid);
    const f32x2 bb = *(const f32x2*)(dwb + 2 * tid);
    f32x4 gv[4];
#pragma unroll
    for (int q = 0; q < 4; ++q) gv[q] = *(const f32x4*)(ng + 4 * lane + 256 * q);
    for (int u = blockIdx.x; u < nunits; u += gridDim.x) {
        const int t0 = u * 16; const int lo = (t0 < T_) ? 0 : T_, hi = (t0 < T_) ? T_ : MT_;
        f32x2 av[16];
#pragma unroll
        for (int i = 0; i < 16; ++i) av[i] = bb;
        unsigned raws[46];
#pragma unroll
        for (int r = 0; r < 46; ++r) { const int row = t0 - 15 + r; const int rowc = (row >= lo && row < hi) ? row : t0; raws[r] = *(const unsigned*)(Y1 + (size_t)rowc * 1024 + 2 * tid); }
        __builtin_amdgcn_sched_barrier(0);
#pragma unroll
        for (int r = 0; r < 46; ++r) {
            const int row = t0 - 15 + r; const bool inr = (row >= lo && row < hi); const unsigned raw = raws[r];
            f32x2 vv; vv.x = inr ? __uint_as_float(raw << 16) : 0.f; vv.y = inr ? __uint_as_float(raw & 0xffff0000u) : 0.f;
#pragma unroll
            for (int i = 0; i < 16; ++i) { const int w = r - i; if (w >= 0 && w < 31) av[i] = __builtin_elementwise_fma(wv[w], vv, av[i]); }
        }
#pragma unroll
        for (int i = 0; i < 16; ++i) *(LAS f32x2*)(tile + i * 1024 + 2 * tid) = av[i];
        __syncthreads();
#pragma unroll
        for (int ii = 0; ii < 2; ++ii) {
            const int i = wave * 2 + ii;
            f32x4 v[4]; float s = 0.f;
#pragma unroll
            for (int q = 0; q < 4; ++q) { v[q] = *(const LAS f32x4*)(tile + i * 1024 + 4 * lane + 256 * q); s += (v[q][0] + v[q][1]) + (v[q][2] + v[q][3]); }
            const float mean = wave_sum(s) * (1.0f / 1024.0f); float s2 = 0.f;
#pragma unroll
            for (int q = 0; q < 4; ++q) { v[q] = v[q] - mean; s2 += (v[q][0] * v[q][0] + v[q][1] * v[q][1]) + (v[q][2] * v[q][2] + v[q][3] * v[q][3]); }
            const float rstd = rsqrtf(wave_sum(s2) * (1.0f / 1024.0f) + 1e-6f);
#pragma unroll
            for (int q = 0; q < 4; ++q) { f32x4 y = v[q] * rstd * gv[q]; y[0] = silu_f(y[0]); y[1] = silu_f(y[1]); y[2] = silu_f(y[2]); y[3] = silu_f(y[3]);
                st4bf(Y2 + (size_t)(t0 + i) * 1024 + 4 * lane + 256 * q, y); }
        }
        __syncthreads();
    }
}

__device__ __forceinline__ int crow(int r, int hi) { return (r & 3) + 8 * (r >> 2) + 4 * hi; }
__device__ __forceinline__ void phase_attn(const LP& p, int j, LAS unsigned char* lds) {
    const bf16* Q = (const bf16*)(p.ws() + WS_AQ); const bf16* K = (const bf16*)(p.ws() + WS_AK); const bf16* VT = (const bf16*)(p.ws() + WS_AVT); bf16* AO = (bf16*)(p.ws() + WS_AO);
    const float* sink = p.in(21) + j * 16;
    LAS unsigned char* Kl = lds; LAS unsigned char* Vl = lds + 3 * 18432;
    for (int u = blockIdx.x; u < 128 * 4; u += gridDim.x) {
        int tid = threadIdx.x; asm volatile("" : "+v"(tid));
        const int lane = tid & 63, wave = tid >> 6, l31 = lane & 31, hi = lane >> 5;
        const int blk = u >> 2, kh = u & 3; const int rb = 128 * blk;
        const int qh = 4 * kh + (wave >> 1); const int qoff = 64 * (wave & 1);
        bf16x8 qop[2][4];
#pragma unroll
        for (int qt = 0; qt < 2; ++qt)
#pragma unroll
            for (int ks = 0; ks < 4; ++ks) qop[qt][ks] = *(const bf16x8*)(Q + (size_t)(rb + qoff + 32 * qt + l31) * 1024 + 64 * qh + 16 * ks + 8 * hi);
        f32x16 o[2][2]; float lsum[2] = {0.f, 0.f};
#pragma unroll
        for (int a2 = 0; a2 < 2; ++a2)
#pragma unroll
            for (int b = 0; b < 2; ++b)
#pragma unroll
                for (int r = 0; r < 16; ++r) o[a2][b][r] = 0.f;
#pragma unroll 1
        for (int g = 0; g < 2; ++g) {
            if (g == 1 && blk >= 128) break;
            __syncthreads();
#pragma unroll 1
            for (int s3 = 0; s3 < 3 - g; ++s3) {
                const int kb = 3 * g + s3; int kr; bool valid = true;
                if (kb < 2) kr = T_ + 128 * kb; else { const int nb = blk + kb - 3; valid = (blk < 128) && nb >= 0 && nb <= 127; kr = 128 * nb; }
                if (!valid) continue;
                LAS unsigned char* Ks = Kl + s3 * 18432; LAS unsigned char* Vs = Vl + s3 * 17408;
                u32x4 kst2[2], vst2[2];
#pragma unroll
                for (int i = 0; i < 2; ++i) {
                    const int pid = tid + 512 * i;
                    { const int key = pid >> 3, pc = pid & 7; kst2[i] = *(const u32x4*)(K + (size_t)(kr + key) * 256 + 64 * kh + 8 * pc); }
                    { const int d = pid >> 4, pc = pid & 15; vst2[i] = *(const u32x4*)(VT + ((size_t)(kr >> 7) * 256 + 64 * kh + d) * 128 + 8 * pc); }
                }
                __builtin_amdgcn_sched_barrier(0);
#pragma unroll
                for (int i = 0; i < 2; ++i) {
                    const int pid = tid + 512 * i;
                    { const int key = pid >> 3, pc = pid & 7; *(LAS u32x4*)(Ks + key * 144 + 16 * pc) = kst2[i]; }
                    { const int d = pid >> 4, pc = pid & 15; *(LAS u32x4*)(Vs + d * 272 + 16 * pc) = vst2[i]; }
                }
            }
            __syncthreads();
#pragma unroll 1
            for (int s3 = 0; s3 < 3 - g; ++s3) {
                const int kb = 3 * g + s3; int type = 0; bool valid = true;
                if (kb >= 2) { const int nb = blk + kb - 3; valid = (blk < 128) && nb >= 0 && nb <= 127; type = (kb == 2) ? 1 : (kb == 4) ? 2 : 0; }
                if (!valid) continue;
                const LAS unsigned char* Ks = Kl + s3 * 18432; const LAS unsigned char* Vs = Vl + s3 * 17408;
                int l31m = l31, him = hi; asm volatile("" : "+v"(l31m), "+v"(him));
                const int msgn = (type == 1) ? 1 : (type == 2) ? -1 : 0;
#pragma unroll 1
                for (int st = 0; st < 4; ++st) {
                    bf16x8 kf[4];
#pragma unroll
                    for (int ks = 0; ks < 4; ++ks) kf[ks] = *(const LAS bf16x8*)(Ks + (32 * st + l31) * 144 + (16 * ks + 8 * hi) * 2);
                    u32x4 vf[2][2];
#pragma unroll
                    for (int dt = 0; dt < 2; ++dt)
#pragma unroll
                        for (int h2 = 0; h2 < 2; ++h2) {
                            const LAS unsigned char* vb = Vs + (32 * dt + l31) * 272 + (32 * st + 16 * h2 + 4 * hi) * 2;
                            const u32x2 b0 = *(const LAS u32x2*)vb, b1 = *(const LAS u32x2*)(vb + 16);
                            vf[dt][h2] = (u32x4){b0.x, b0.y, b1.x, b1.y};
                        }
#pragma unroll
                    for (int qt = 0; qt < 2; ++qt) {
                        const int a = qoff + 32 * qt + l31m;
                        f32x16 pp;
#pragma unroll
                        for (int r = 0; r < 16; ++r) pp[r] = 0.f;
#pragma unroll
                        for (int ks = 0; ks < 4; ++ks) pp = __builtin_amdgcn_mfma_f32_32x32x16_bf16(kf[ks], qop[qt][ks], pp, 0, 0, 0);
                        float ls = 0.f;
#pragma unroll
                        for (int r = 0; r < 16; ++r) { const int b = 32 * st + crow(r, him); const int dd = msgn * (b - a); const float e = __uint_as_float(__float_as_uint(__expf(pp[r])) & ~(unsigned)(dd >> 31)); pp[r] = e; ls += e; }
                        lsum[qt] += ls;
                        u32x4 pa[2];
#pragma unroll
                        for (int h2 = 0; h2 < 2; ++h2) { pa[h2].x = pk2(pp[8 * h2 + 0], pp[8 * h2 + 1]); pa[h2].y = pk2(pp[8 * h2 + 2], pp[8 * h2 + 3]); pa[h2].z = pk2(pp[8 * h2 + 4], pp[8 * h2 + 5]); pa[h2].w = pk2(pp[8 * h2 + 6], pp[8 * h2 + 7]); }
#pragma unroll
                        for (int dt = 0; dt < 2; ++dt)
#pragma unroll
                            for (int h2 = 0; h2 < 2; ++h2)
                                o[qt][dt] = __builtin_amdgcn_mfma_f32_32x32x16_bf16(__builtin_bit_cast(bf16x8, pa[h2]), __builtin_bit_cast(bf16x8, vf[dt][h2]), o[qt][dt], 0, 0, 0);
                    }
                }
            }
        }
        const float esink = __expf(sink[qh]);
#pragma unroll
        for (int qt = 0; qt < 2; ++qt) {
            float ltot = lsum[qt] + __shfl_xor(lsum[qt], 32);
            const float inv = 1.0f / (ltot + esink);
#pragma unroll
            for (int r = 0; r < 16; ++r) {
                const int qr = crow(r, hi); const float iv = __shfl(inv, qr);
                bf16* op = AO + (size_t)(rb + qoff + 32 * qt + qr) * 1024 + 64 * qh + l31;
                op[0] = (bf16)(pk2(o[qt][0][r] * iv, 0.f) & 0xffffu); op[32] = (bf16)(pk2(o[qt][1][r] * iv, 0.f) & 0xffffu);
            }
        }
    }
}

__device__ __forceinline__ float log_sigmoid_f(float x) { return -log1pf(__expf(-x)); }
struct ScanCtx { int h, dir, sl; float lg; bool active; };
__device__ __forceinline__ void scan_part(const LP& p, const ScanCtx& sc, int part, LAS unsigned char* lds) {
    int tid = threadIdx.x; asm volatile("" : "+v"(tid));
    const int lane = tid & 63, wave = tid >> 6, l31 = lane & 31, hi = lane >> 5, l15 = lane & 15, kq = lane >> 4;
    const bf16* Q = (const bf16*)(p.ws() + WS_RQ); const bf16* KT = (const bf16*)(p.ws() + WS_RKT); const bf16* VT = (const bf16*)(p.ws() + WS_RVT);
    bf16* OI = (bf16*)(p.ws() + WS_ROI); bf16* OIC = (bf16*)(p.ws() + WS_ROIC) + (size_t)sc.dir * 256 * 2048;
    LAS unsigned char* KTl = lds; LAS unsigned char* VTl = lds + 69632; LAS unsigned char* Stl = lds + 69632 + 8704;
    const int h = sc.h, dir = sc.dir, sl = sc.sl; const float lg = sc.lg;
    const float cd = __expf(lg * 128.0f);
    const int nsteps = (part == 0) ? 66 : 64;
    LAS float* kdt = (LAS float*)(lds + 96768); LAS float* qdt = (LAS float*)(lds + 97280);
    if (tid < 128) { const int m = tid; kdt[m] = __expf(lg * (float)(dir ? m : 127 - m)); qdt[m] = __expf(lg * (float)(dir ? 128 - m : m + 1)); }
    u32x4 vreg; bf16x8 kop[8], qA[8], qB[8];
#define SCAN_RB(s) (((part) == 0) ? (((s) < 2) ? (T_ + 128 * (dir ? 1 - (s) : (s))) : 128 * (dir ? 127 - ((s) - 2) : ((s) - 2))) : 128 * (dir ? 63 - (s) : 64 + (s)))
#define SCAN_LOAD_QV(rbv, QN) do { \
        const bf16* vb_ = VT + ((size_t)((rbv) >> 7) * 2048 + 512 * h + 32 * sl) * 128; const bf16* qb_ = Q + (((size_t)((rbv) >> 7) * 4 + h) * 8 + wave) * 4096; \
        vreg = *(const u32x4*)(vb_ + koff); \
        _Pragma("unroll") for (int ks = 0; ks < 8; ++ks) QN[ks] = *(const bf16x8*)(qb_ + ks * 512 + 8 * lane); } while (0)
#define SCAN_LOAD_K(rbv) do { \
        const bf16* kb_ = KT + (((size_t)((rbv) >> 7) * 4 + h) * 8 + wave) * 4096; \
        _Pragma("unroll") for (int ks = 0; ks < 8; ++ks) kop[ks] = *(const bf16x8*)(kb_ + ks * 512 + 8 * lane); } while (0)
    const int koff = (tid >> 4) * 128 + 8 * (tid & 15), qoff = (16 * wave + l15) * 1024 + 8 * kq;
    if (!sc.active) return;
    float* Ssave = (float*)(p.ws() + WS_ROIC + 2 * MiB) + (size_t)(sc.h + 4 * sc.dir + 8 * sc.sl) * 8192 + (size_t)tid * 16;
    f32x16 S;
    if (part == 0) {
#pragma unroll
        for (int r = 0; r < 16; ++r) S[r] = 0.f;
    } else {
#pragma unroll
        for (int r = 0; r < 4; ++r) { const f32x4 t = *(const f32x4*)(Ssave + 4 * r); S[4 * r] = t[0]; S[4 * r + 1] = t[1]; S[4 * r + 2] = t[2]; S[4 * r + 3] = t[3]; }
    }
    LAS int* rbtab = (LAS int*)(lds + 96256);
    if (tid <= nsteps) { const int st_ = (tid < nsteps) ? tid : nsteps - 1; rbtab[tid] = SCAN_RB(st_); }
    __syncthreads();
    { const int rb0 = rfl_i(rbtab[0]); SCAN_LOAD_QV(rb0, qA); SCAN_LOAD_K(rb0); }
    float pend[2][4] = {{0.f, 0.f, 0.f, 0.f}, {0.f, 0.f, 0.f, 0.f}}; unsigned short oiv[2][4] = {{0, 0, 0, 0}, {0, 0, 0, 0}};
    typedef __attribute__((address_space(1))) unsigned short g16;
    g16* const WSB = (g16*)p.ws();
    const int ooff = (16 * wave + 4 * kq) * 2048 + 512 * h + 32 * sl + l15;
    size_t pbu = (WS_ROIC + 6 * MiB) / 2;
#define SCAN_FLUSH() do { { \
        _Pragma("unroll") for (int nt = 0; nt < 2; ++nt) _Pragma("unroll") for (int jj = 0; jj < 4; ++jj) { \
            float v = pend[nt][jj]; v += (part == 1) ? bf2f(oiv[nt][jj]) : 0.f; (WSB + pbu + jj * 2048 + 16 * nt)[ooff] = (unsigned short)(pk2(v, 0.f) & 0xffffu); } } } while (0)
#define SCAN_STEP(SIDX, QC, QN) do { const int s = (SIDX); \
        const int rb = rfl_i(rbtab[s]); \
        { const int e = tid >> 4, pc = tid & 15; u32x4 w; const f32x4 kda = *(const LAS f32x4*)(kdt + 8 * pc), kdb = *(const LAS f32x4*)(kdt + 8 * pc + 4); const float kd[8] = {kda[0], kda[1], kda[2], kda[3], kdb[0], kdb[1], kdb[2], kdb[3]}; \
          w.x = pk2(__uint_as_float(vreg.x << 16) * kd[0], __uint_as_float(vreg.x & 0xffff0000u) * kd[1]); \
          w.y = pk2(__uint_as_float(vreg.y << 16) * kd[2], __uint_as_float(vreg.y & 0xffff0000u) * kd[3]); \
          w.z = pk2(__uint_as_float(vreg.z << 16) * kd[4], __uint_as_float(vreg.z & 0xffff0000u) * kd[5]); \
          w.w = pk2(__uint_as_float(vreg.w << 16) * kd[6], __uint_as_float(vreg.w & 0xffff0000u) * kd[7]); \
          *(LAS u32x4*)(VTl + e * 272 + 16 * pc) = w; } \
        _Pragma("unroll") for (int g4 = 0; g4 < 4; ++g4) { u32x2 w; w.x = pk2(S[4 * g4 + 0], S[4 * g4 + 1]); w.y = pk2(S[4 * g4 + 2], S[4 * g4 + 3]); \
            *(LAS u32x2*)(Stl + l31 * 528 + (32 * wave + 8 * g4 + 4 * hi) * 2) = w; } \
        SCAN_FLUSH(); \
        __syncthreads(); \
        const size_t obu = (rb >= T_) ? ((WS_ROIC / 2) + (size_t)dir * 256 * 2048 + (size_t)(rb - T_) * 2048) : ((WS_ROI / 2) + (size_t)rb * 2048); \
        _Pragma("unroll") for (int nt = 0; nt < 2; ++nt) _Pragma("unroll") for (int jj = 0; jj < 4; ++jj) oiv[nt][jj] = (WSB + obu + jj * 2048 + 16 * nt)[ooff]; \
        asm volatile("" ::: "memory"); \
        const int rbn = rfl_i(rbtab[s + 1]); \
        SCAN_LOAD_QV(rbn, QN); \
        __builtin_amdgcn_sched_barrier(0); \
        _Pragma("unroll") for (int r = 0; r < 16; ++r) S[r] *= cd; \
        { bf16x8 vb[8]; \
          _Pragma("unroll") for (int ks = 0; ks < 8; ++ks) vb[ks] = *(const LAS bf16x8*)(VTl + l31 * 272 + (16 * ks + 8 * hi) * 2); \
          __builtin_amdgcn_sched_barrier(0); \
          _Pragma("unroll") for (int ks = 0; ks < 8; ++ks) S = __builtin_amdgcn_mfma_f32_32x32x16_bf16(kop[ks], vb[ks], S, 0, 0, 0); } \
        __builtin_amdgcn_sched_barrier(0); \
        SCAN_LOAD_K(rbn); \
        __builtin_amdgcn_sched_barrier(0); \
        _Pragma("unroll") for (int nt = 0; nt < 2; ++nt) { \
            f32x4 acc = (f32x4){0.f, 0.f, 0.f, 0.f}; \
            { bf16x8 sb[8]; \
              _Pragma("unroll") for (int ks = 0; ks < 8; ++ks) sb[ks] = *(const LAS bf16x8*)(Stl + (16 * nt + l15) * 528 + (32 * ks + 8 * kq) * 2); \
              __builtin_amdgcn_sched_barrier(0); \
              _Pragma("unroll") for (int ks = 0; ks < 8; ++ks) acc = __builtin_amdgcn_mfma_f32_16x16x32_bf16(QC[ks], sb[ks], acc, 0, 0, 0); } \
            { const f32x4 qdv = *(const LAS f32x4*)(qdt + 16 * wave + 4 * kq); _Pragma("unroll") for (int jj = 0; jj < 4; ++jj) pend[nt][jj] = acc[jj] * qdv[jj]; } } \
        pbu = obu; \
        __syncthreads(); \
    } while (0)
    for (int s2 = 0; s2 < nsteps; s2 += 2) { SCAN_STEP(s2, qA, qB); SCAN_STEP(s2 + 1, qB, qA); }
    SCAN_FLUSH();
#undef SCAN_STEP
#undef SCAN_FLUSH
    if (part == 0) {
#pragma unroll
        for (int r = 0; r < 4; ++r) *(f32x4*)(Ssave + 4 * r) = (f32x4){S[4 * r], S[4 * r + 1], S[4 * r + 2], S[4 * r + 3]};
    }
#undef SCAN_RB
#undef SCAN_LOAD
}

__device__ __forceinline__ void phase_ret_intra(const LP& p, int j, LAS unsigned char* lds, int ubeg, int uend, int bidx, int bstride) {
    const bf16* Q = (const bf16*)(p.ws() + WS_RQ); const bf16* K = (const bf16*)(p.ws() + WS_RK); const bf16* VT = (const bf16*)(p.ws() + WS_RVT);
    bf16* G = (bf16*)(p.ws() + WS_RG); const bf16* OI = (const bf16*)(p.ws() + WS_ROI); const bf16* OIC = (const bf16*)(p.ws() + WS_ROIC);
    LAS unsigned char* Kl = lds; LAS unsigned char* Vl = lds + 67584;
    for (int u = ubeg + bidx; u < uend; u += bstride) {
        int tid = threadIdx.x; asm volatile("" : "+v"(tid));
        const int lane = tid & 63, wave = tid >> 6, l15 = lane & 15, kq = lane >> 4;
        const int c = u >> 2, h = u & 3; const int rb = 128 * c;
        const float lgf = log_sigmoid_f(p.in(15)[j * 4 + h]), lgb = log_sigmoid_f(p.in(16)[j * 4 + h]);
        __syncthreads();
        u32x4 kst[8];
#pragma unroll
        for (int i = 0; i < 8; ++i) { const int pid = tid + 512 * i; const int key = pid >> 5, pc = pid & 31; kst[i] = *(const u32x4*)(K + (size_t)(rb + key) * 1024 + 256 * h + 8 * pc); }
        __builtin_amdgcn_sched_barrier(0);
#pragma unroll
        for (int i = 0; i < 8; ++i) { const int pid = tid + 512 * i; const int key = pid >> 5, pc = pid & 31; *(LAS u32x4*)(Kl + key * 528 + 16 * pc) = kst[i]; }
        bf16x8 qop[8];
#pragma unroll
        for (int ks = 0; ks < 8; ++ks) qop[ks] = *(const bf16x8*)(Q + ((((size_t)(rb >> 7) * 4 + h) * 8 + wave) * 8 + ks) * 512 + 8 * lane);
        __syncthreads();
        u32x2 pk[8];
        const int mq = 16 * wave + l15;
#pragma unroll
        for (int kt = 0; kt < 8; ++kt) {
            f32x4 acc = (f32x4){0.f, 0.f, 0.f, 0.f}; bf16x8 ka[8];
#pragma unroll
            for (int ks = 0; ks < 8; ++ks) ka[ks] = *(const LAS bf16x8*)(Kl + (16 * kt + l15) * 528 + (32 * ks + 8 * kq) * 2);
            __builtin_amdgcn_sched_barrier(0);
#pragma unroll
            for (int ks = 0; ks < 8; ++ks) acc = __builtin_amdgcn_mfma_f32_16x16x32_bf16(ka[ks], qop[ks], acc, 0, 0, 0);
            float pv[4];
#pragma unroll
            for (int jj = 0; jj < 4; ++jj) { const int key = 16 * kt + 4 * kq + jj; const int rel = mq - key;
                const float dcy = (rel > 0) ? __expf(lgf * (float)rel) : (rel < 0) ? __expf(-lgb * (float)rel) : 2.0f; pv[jj] = acc[jj] * dcy; }
            pk[kt].x = pk2(pv[0], pv[1]); pk[kt].y = pk2(pv[2], pv[3]);
        }
        bf16* TMP = (rb >= T_) ? (bf16*)OIC + (size_t)(rb - T_) * 2048 : (bf16*)OI + (size_t)rb * 2048;
        const bool isc = rb >= T_;
        LAS float* Ol = (LAS float*)Kl;
        const int prow = tid >> 2, pseg = tid & 3;
        bf16* TMPr = TMP + (size_t)prow * 2048 + 512 * h;
        float ssp = 0.f;
#pragma unroll 1
        for (int es = 0; es < 4; ++es) {
            __syncthreads();
            u32x4 vst[4];
#pragma unroll
            for (int i = 0; i < 4; ++i) { const int pid = tid + 512 * i; const int e = pid >> 4, pc = pid & 15; vst[i] = *(const u32x4*)(VT + ((size_t)(rb >> 7) * 2048 + 512 * h + 128 * es + e) * 128 + 8 * pc); }
            __builtin_amdgcn_sched_barrier(0);
#pragma unroll
            for (int i = 0; i < 4; ++i) { const int pid = tid + 512 * i; const int e = pid >> 4, pc = pid & 15; *(LAS u32x4*)(Vl + e * 272 + 16 * pc) = vst[i]; }
            __syncthreads();
#pragma unroll
            for (int nt = 0; nt < 8; ++nt) {
                f32x4 acc = (f32x4){0.f, 0.f, 0.f, 0.f}; u32x4 bwv[4];
#pragma unroll
                for (int kp = 0; kp < 4; ++kp) {
                    const LAS unsigned char* vb = Vl + (16 * nt + l15) * 272 + (32 * kp + 4 * kq) * 2;
                    const u32x2 b0 = *(const LAS u32x2*)vb, b1 = *(const LAS u32x2*)(vb + 32);
                    bwv[kp] = (u32x4){b0.x, b0.y, b1.x, b1.y};
                }
                __builtin_amdgcn_sched_barrier(0);
#pragma unroll
                for (int kp = 0; kp < 4; ++kp) {
                    const u32x4 aw = (u32x4){pk[2 * kp].x, pk[2 * kp].y, pk[2 * kp + 1].x, pk[2 * kp + 1].y};
                    acc = __builtin_amdgcn_mfma_f32_16x16x32_bf16(__builtin_bit_cast(bf16x8, aw), __builtin_bit_cast(bf16x8, bwv[kp]), acc, 0, 0, 0);
                }
#pragma unroll
                for (int jj = 0; jj < 4; ++jj) Ol[(16 * wave + 4 * kq + jj) * 132 + 16 * nt + l15] = acc[jj];
            }
            __syncthreads();
            u32x4 oiq[4], ojq[4];
#pragma unroll
            for (int q = 0; q < 4; ++q) { const bf16* tp0 = TMPr + 128 * es + 32 * pseg + 8 * q; oiq[q] = *(const u32x4*)tp0; ojq[q] = (u32x4){0u, 0u, 0u, 0u}; if (isc) ojq[q] = *(const u32x4*)(tp0 + (size_t)256 * 2048); }
            __builtin_amdgcn_sched_barrier(0);
#pragma unroll
            for (int q = 0; q < 4; ++q) {
                const int e0 = 32 * pseg + 8 * q; bf16* tp = TMPr + 128 * es + e0;
                const u32x4 oi = oiq[q];
                const u32x4 oj = ojq[q];
                const f32x4 o0 = *(const LAS f32x4*)(Ol + prow * 132 + e0), o1 = *(const LAS f32x4*)(Ol + prow * 132 + e0 + 4);
                float v[8];
                v[0] = o0[0] + __uint_as_float(oi.x << 16) + __uint_as_float(oj.x << 16); v[1] = o0[1] + __uint_as_float(oi.x & 0xffff0000u) + __uint_as_float(oj.x & 0xffff0000u);
                v[2] = o0[2] + __uint_as_float(oi.y << 16) + __uint_as_float(oj.y << 16); v[3] = o0[3] + __uint_as_float(oi.y & 0xffff0000u) + __uint_as_float(oj.y & 0xffff0000u);
                v[4] = o1[0] + __uint_as_float(oi.z << 16) + __uint_as_float(oj.z << 16); v[5] = o1[1] + __uint_as_float(oi.z & 0xffff0000u) + __uint_as_float(oj.z & 0xffff0000u);
                v[6] = o1[2] + __uint_as_float(oi.w << 16) + __uint_as_float(oj.w << 16); v[7] = o1[3] + __uint_as_float(oi.w & 0xffff0000u) + __uint_as_float(oj.w & 0xffff0000u);
#pragma unroll
                for (int e = 0; e < 8; ++e) ssp += v[e] * v[e];
                u32x4 w; w.x = pk2(v[0], v[1]); w.y = pk2(v[2], v[3]); w.z = pk2(v[4], v[5]); w.w = pk2(v[6], v[7]);
                *(u32x4*)tp = w;
            }
        }
        ssp += __shfl_xor(ssp, 1); ssp += __shfl_xor(ssp, 2);
        const float rstd = rsqrtf(ssp * (1.0f / 512.0f) + 1e-6f);
        bf16* Gr = G + (size_t)(rb + prow) * 2048 + 512 * h;
#pragma unroll
        for (int es = 0; es < 4; ++es) {
            u32x4 tvq[4], gvq[4];
#pragma unroll
            for (int q = 0; q < 4; ++q) { const int col = 128 * es + 32 * pseg + 8 * q; tvq[q] = *(const u32x4*)(TMPr + col); gvq[q] = *(const u32x4*)(Gr + col); }
            __builtin_amdgcn_sched_barrier(0);
#pragma unroll
            for (int q = 0; q < 4; ++q) {
                const int col = 128 * es + 32 * pseg + 8 * q;
                const u32x4 tv = tvq[q], gv = gvq[q];
                u32x4 w;
                w.x = pk2(__uint_as_float(tv.x << 16) * rstd * __uint_as_float(gv.x << 16), __uint_as_float(tv.x & 0xffff0000u) * rstd * __uint_as_float(gv.x & 0xffff0000u));
                w.y = pk2(__uint_as_float(tv.y << 16) * rstd * __uint_as_float(gv.y << 16), __uint_as_float(tv.y & 0xffff0000u) * rstd * __uint_as_float(gv.y & 0xffff0000u));
                w.z = pk2(__uint_as_float(tv.z << 16) * rstd * __uint_as_float(gv.z << 16), __uint_as_float(tv.z & 0xffff0000u) * rstd * __uint_as_float(gv.z & 0xffff0000u));
                w.w = pk2(__uint_as_float(tv.w << 16) * rstd * __uint_as_float(gv.w << 16), __uint_as_float(tv.w & 0xffff0000u) * rstd * __uint_as_float(gv.w & 0xffff0000u));
                *(u32x4*)(Gr + col) = w;
            }
        }
    }
}

#define XB_TMO      128
#define XB_XCNT(j)  (256  + 64 * (j))
#define XB_XSUB(j)  (1280 + 64 * (j))
#define XB_XGEN(j)  (2304 + 64 * (j))
#define XB_TOP      3328
#define XB_TOPGEN   3392
#define XCD_BAR_WORDS 3456
#define XB_SPIN_CAP (1u << 18)

__device__ __forceinline__ unsigned xb_ld(unsigned* p)              { return __hip_atomic_load(p, __ATOMIC_RELAXED, __HIP_MEMORY_SCOPE_AGENT); }
__device__ __forceinline__ unsigned xb_add(unsigned* p, unsigned v) { return __hip_atomic_fetch_add(p, v, __ATOMIC_RELAXED, __HIP_MEMORY_SCOPE_AGENT); }
__device__ __forceinline__ unsigned xb_xcc_id() { return (unsigned)__builtin_amdgcn_s_getreg((3 << 11) | 20) & 0xFu; }
#define XB_SPIN(cond, bar) do { unsigned _sp = 0; while (cond) { __builtin_amdgcn_s_sleep(1); \
    if ((++_sp & 255u) == 0u) { if (xb_ld(&(bar)[XB_TMO])) break; if (_sp > XB_SPIN_CAP) { atomicAdd(&(bar)[XB_TMO], 1u); break; } } } } while (0)

struct XcdBarrier {
    unsigned* bar; unsigned x;
    volatile LAS unsigned* st;
};

__device__ __forceinline__ XcdBarrier xcd_barrier_post(unsigned* bar, volatile LAS unsigned* st) {
    XcdBarrier b; b.bar = bar; b.x = xb_xcc_id(); b.st = st;
    if (threadIdx.x == 0) (void)xb_add(&bar[XB_XCNT(b.x)], 1u);
    return b;
}
__device__ __forceinline__ void xcd_barrier_complete(unsigned* bar, unsigned x, unsigned& nloc, unsigned& nx) {
    const unsigned G = gridDim.x * gridDim.y * gridDim.z;
    unsigned sum, cnt, mine, sp = 0u;
    for (;;) {
        sum = 0u; cnt = 0u; mine = 0u;
#pragma unroll
        for (unsigned j = 0; j < 16; ++j) { const unsigned c = xb_ld(&bar[XB_XCNT(j)]); sum += c; cnt += (c > 0u) ? 1u : 0u; mine = (j == x) ? c : mine; }
        if (sum == G) break;
        __builtin_amdgcn_s_sleep(1);
        if ((++sp & 255u) == 0u) { if (xb_ld(&bar[XB_TMO])) break; if (sp > XB_SPIN_CAP) { atomicAdd(&bar[XB_TMO], 1u); break; } }
    }
    nloc = mine > 0u ? mine : 1u; nx = cnt > 0u ? cnt : 1u;
}

__device__ __forceinline__ void xcd_barrier(const XcdBarrier& b) {
    asm volatile("s_waitcnt vmcnt(0)" ::: "memory");
    __syncthreads();
    if (threadIdx.x == 0) {
        unsigned* bar = b.bar;
        __builtin_amdgcn_s_waitcnt(0);
        unsigned nloc = b.st[0], nx = b.st[1];
        if (nloc == 0u) { xcd_barrier_complete(bar, b.x, nloc, nx); b.st[0] = nloc; b.st[1] = nx; }
        const unsigned old = xb_add(&bar[XB_XSUB(b.x)], 1u);
        const unsigned gen = old / nloc;
        if (old + 1u == (gen + 1u) * nloc) {
            __builtin_amdgcn_fence(__ATOMIC_RELEASE, "agent");
            asm volatile("s_waitcnt vmcnt(0)" ::: "memory");
            const unsigned og = xb_add(&bar[XB_TOP], 1u);
            const unsigned tg = og / nx;
            if (og + 1u == (tg + 1u) * nx) xb_add(&bar[XB_TOPGEN], 1u);
            else XB_SPIN(xb_ld(&bar[XB_TOPGEN]) == tg, bar);
            __builtin_amdgcn_fence(__ATOMIC_ACQUIRE, "agent");
            xb_add(&bar[XB_XGEN(b.x)], 1u);
            asm volatile("s_waitcnt vmcnt(0)" ::: "memory");
        } else {
            XB_SPIN(xb_ld(&bar[XB_XGEN(b.x)]) == gen, bar);
            __builtin_amdgcn_fence(__ATOMIC_ACQUIRE, "agent");
            asm volatile("s_waitcnt vmcnt(0)" ::: "memory");
        }
    }
    __syncthreads();
}

constexpr int XBST_OFF = 131072 + 480;
__global__ void __launch_bounds__(NTHREADS, 2) fwd_megakernel(Params pin) {
    extern __shared__ __attribute__((aligned(16))) unsigned char lds_raw[];
    LAS unsigned char* lds = (LAS unsigned char*)lds_raw;
    cg::grid_group grid = cg::this_grid();
    {
        LAS unsigned long long* lp = (LAS unsigned long long*)(lds + PARAM_OFF);
        if (threadIdx.x < 25) lp[threadIdx.x] = (unsigned long long)pin.in[threadIdx.x];
        if (threadIdx.x == 25) lp[25] = (unsigned long long)pin.out;
        if (threadIdx.x == 26) lp[26] = (unsigned long long)pin.ws;
        __syncthreads();
    }
    LP p; p.q = (const LAS unsigned long long*)(lds + PARAM_OFF);
    if (threadIdx.x < 2) ((volatile LAS unsigned*)(lds + XBST_OFF))[threadIdx.x] = 0u;
    if (threadIdx.x == 0) {
        const unsigned x = xb_xcc_id();
        const unsigned r = __hip_atomic_fetch_add((unsigned*)(pin.ws + WS_BAR + 16384) + 64 * x, 1u, __ATOMIC_RELAXED, __HIP_MEMORY_SCOPE_AGENT);
        *(volatile LAS int*)(lds + VCU_OFF) = (int)(r * 16u + x);
    }
    __syncthreads();
    (void)xcd_barrier_post((unsigned*)(pin.ws + WS_BAR), (volatile LAS unsigned*)(lds + XBST_OFF));
#define GRID_BAR() do { XcdBarrier b_; b_.bar = (unsigned*)(p.ws() + WS_BAR); b_.x = xb_xcc_id(); b_.st = (volatile LAS unsigned*)(lds + XBST_OFF); xcd_barrier(b_); } while (0)
    { const float* cin = p.in(2); float* XC0 = (float*)(p.ws() + WS_XC);
      for (int i = blockIdx.x * NTHREADS + threadIdx.x; i < L_ * D_ / 4; i += gridDim.x * NTHREADS) ((f32x4*)XC0)[i] = ((const f32x4*)cin)[i]; }
    phase_adaln_partial(p);
    convert_mixer(p, 0, lds, (int)blockIdx.x, (int)gridDim.x);
    convert_ffn(p, 0, lds, (int)blockIdx.x, (int)gridDim.x);
    GRID_BAR();
    if (threadIdx.x == 0) {
        const unsigned* rw = (const unsigned*)(p.ws() + WS_BAR + 16384); const unsigned G = gridDim.x; bool ok = (G % 8u) == 0u;
        for (int jx = 0; jx < 8; ++jx) ok = ok && (__hip_atomic_load(rw + 64 * jx, __ATOMIC_RELAXED, __HIP_MEMORY_SCOPE_AGENT) == G / 8u);
        const int pk = *(volatile LAS int*)(lds + VCU_OFF); const int r = pk >> 4, x = pk & 15;
        *(volatile LAS int*)(lds + VCU_OFF) = (ok && x < 8) ? (r * 8 + x) : (int)blockIdx.x;
    }
    __syncthreads();
    phase_adaln_reduce(p);
    GRID_BAR();
    if (gridDim.x == 0x7fffffffu) grid.sync();
#pragma unroll 1
    for (int l = 0; l < 4; ++l) {
#pragma unroll 1
        for (int st = 0; st < 10; ++st) {
            const int kind = l % 3, j = l / 3;
            const bool isg = (st == 1) || (st == 2 && kind != 0) || st == 6 || st == 8 || st == 9;
            const bool did = !((st == 2 && kind == 0) || (st == 4 && kind != 1) || (st == 5 && kind != 1) || (st == 1 && kind != 0));
            if (isg) {
                if (threadIdx.x == 0) {
                    volatile LAS EpiD* e = (volatile LAS EpiD*)(lds + DESC_OFF);
                    unsigned char* ws = p.ws();
                    float* mods = (float*)(ws + WS_MODS); float* XC = (float*)(ws + WS_XC);
                    bf16* HX = (bf16*)(ws + WS_HX); bf16* WM = (bf16*)(ws + WS_WM); bf16* WF = (bf16*)(ws + WS_WF);
                    float* outp = p.out();
                    e->baseL = (l == 0) ? p.in(0) : outp; e->baseC = XC; e->outL = outp; e->outC = XC;
                    e->gateL = mods + (size_t)(l * 2 + 0) * 6144 + 2048; e->gateC = mods + (size_t)(l * 2 + 1) * 6144 + 2048;
                    e->ldc = 1024; e->part = (float*)(ws + WS_R + ((st == 9) ? 100 * MiB : 0));
                    if (st == 1) {
                        e->A = HX; e->Bt = WM; e->M = (l == 3) ? T_ : MT_; e->K = 1024;
                        if (kind == 0) { e->mode = EM_GLU; e->o0 = (bf16*)(ws + WS_Y1); e->bias = p.in(9) + j * 2048; e->N = 2048; }
                        else if (kind == 1) { e->mode = EM_RET; e->o0 = (bf16*)(ws + WS_RQ); e->o1 = (bf16*)(ws + WS_RG); e->o2 = (bf16*)(ws + WS_RK); e->N = 4096; }
                        else { e->mode = EM_ATT; e->o0 = (bf16*)(ws + WS_AQ); e->o1 = (bf16*)(ws + WS_AK); e->gq = p.in(19) + j * 64; e->gk = p.in(20) + j * 64; e->N = 1280; }
                    } else if (st == 2) {
                        e->Bt = HX; e->N = MT_; e->K = 1024;
                        if (kind == 1) { e->mode = EM_RETT; e->o0 = (bf16*)(ws + WS_RKT); e->o1 = (bf16*)(ws + WS_RVT); e->A = WM + (size_t)3072 * 1024; e->M = 3072; }
                        else { e->mode = EM_PLAIN; e->o0 = (bf16*)(ws + WS_AVT); e->ldc = 256; e->A = WM + (size_t)1280 * 1024; e->M = 256; }
                    } else if (st == 6) {
                        e->mode = EM_RES; e->M = (l >= 2) ? T_ : MT_; e->N = 1024;
                        if (kind == 0) { e->A = (const bf16*)(ws + WS_Y2); e->Bt = WM + 4 * MiB / 2; e->K = 1024; }
                        else if (kind == 1) { e->A = (const bf16*)(ws + WS_RG); e->Bt = WM + 12 * MiB / 2; e->K = 2048; }
                        else { e->A = (const bf16*)(ws + WS_AO); e->Bt = WM + 4 * MiB / 2; e->K = 1024; }
                    } else if (st == 8) { e->mode = EM_SWIGLU; e->o0 = (bf16*)(ws + WS_H); e->ldc = F_; e->A = HX; e->Bt = WF; e->M = (l >= 2) ? T_ : MT_; e->N = 2 * F_; e->K = 1024; }
                    else { e->mode = EM_RES; e->A = (const bf16*)(ws + WS_H); e->Bt = WF + 11 * MiB / 2; e->M = (l >= 2) ? T_ : MT_; e->N = 1024; e->K = F_;
                        e->baseL = outp; e->baseC = XC; e->gateL = mods + (size_t)(l * 2 + 0) * 6144 + 5120; e->gateC = mods + (size_t)(l * 2 + 1) * 6144 + 5120; }
                }
                __syncthreads();
                run_gemm(lds);
            } else if (st == 0) {
                float* XC = (float*)(p.ws() + WS_XC);
                phase_norm(p, l, false, (l == 0) ? p.in(0) : p.out(), XC, (const float*)(p.ws() + WS_R + 100 * MiB), (l == 0 || l == 3) ? 0 : 22); if (l > 0 && l != 1) convert_ffn(p, l, lds, (int)blockIdx.x, (int)gridDim.x);
            } else if (st == 7) {
                float* XC = (float*)(p.ws() + WS_XC);
                phase_norm(p, l, true, p.out(), XC, (const float*)(p.ws() + WS_R), (l >= 2) ? 0 : (kind == 1 ? 16 : 8)); if (l < 3 && l != 1) convert_mixer(p, l + 1, lds, (int)blockIdx.x, (int)gridDim.x);
            } else if (st == 3 || st == 4) {
                if (kind == 1) {
#ifndef NO_SCAN
                    ScanCtx sc; const int u = rfl_i(*(volatile LAS int*)(lds + VCU_OFF)); sc.active = u < 128; sc.h = u & 3; sc.dir = (u >> 2) & 1; sc.sl = (u >> 3) & 15;
                    sc.lg = log_sigmoid_f((sc.dir ? p.in(16) : p.in(15))[j * 4 + sc.h]);
                    scan_part(p, sc, st - 3, lds);
#endif
#ifndef NO_INTRA
                    if (st == 4 && u >= 128) phase_ret_intra(p, j, lds, 512, 520, u - 128, 128);
                    if (st == 3 && u >= 128) convert_ffn(p, l, lds, u - 128, (int)gridDim.x - 128);
                    if (st == 4 && u >= 136) { __syncthreads(); convert_mixer(p, l + 1, lds, u - 136, (int)gridDim.x - 136); }
#endif
                } else if (st == 3 && kind == 0) {
#ifndef NO_DW
                    phase_dwconv(p, j, (l == 3) ? T_ / 16 : MT_ / 16, lds);
#endif
                } else if (st == 3) {
#ifndef NO_ATTN
                    phase_attn(p, j, lds);
#endif
                }
            } else if (st == 5 && kind == 1) {
#ifndef NO_INTRA
                phase_ret_intra(p, j, lds, 0, 512, (int)blockIdx.x, (int)gridDim.x);
#endif
            }
            if (did) GRID_BAR();
        }
    }
}

extern "C" void kernel_launch(void* const* d_in, const int* in_sizes, int n_in, void* d_out, int out_size, void* d_ws, size_t ws_size, hipStream_t stream) {
    static int grid_blocks = 0;
    if (grid_blocks == 0) {
        if (n_in != 25 || ws_size < WS_END) { fprintf(stderr, "kernel_launch: unexpected n_in %d / ws_size %zu (need %zu)\n", n_in, ws_size, (size_t)WS_END); grid_blocks = -1; return; }
        int dev = 0, cus = 0, per_cu = 0;
        hipGetDevice(&dev);
        hipDeviceGetAttribute(&cus, hipDeviceAttributeMultiprocessorCount, dev);
        if (hipFuncSetAttribute((const void*)fwd_megakernel, hipFuncAttributeMaxDynamicSharedMemorySize, LDS_BYTES) != hipSuccess) { fprintf(stderr, "kernel_launch: hipFuncSetAttribute failed\n"); grid_blocks = -1; return; }
        hipOccupancyMaxActiveBlocksPerMultiprocessor(&per_cu, (const void*)fwd_megakernel, NTHREADS, LDS_BYTES);
        if (per_cu < 1) { fprintf(stderr, "kernel_launch: occupancy query gives %d\n", per_cu); per_cu = 1; }
        (void)hipGetLastError();
        grid_blocks = cus * 1;
        if (grid_blocks < 128) { fprintf(stderr, "kernel_launch: grid %d too small\n", grid_blocks); grid_blocks = -1; return; }
    }
    if (grid_blocks < 0) return;
    Params p{};
    for (int i = 0; i < 25; ++i) p.in[i] = (const float*)d_in[i];
    p.out = (float*)d_out; p.ws = (unsigned char*)d_ws;
    if (hipMemsetAsync((char*)d_ws + WS_BAR, 0, 32768, stream) != hipSuccess) { fprintf(stderr, "kernel_launch: memset failed\n"); return; }
    void* args[] = {&p};
    hipError_t e = hipLaunchCooperativeKernel((void*)fwd_megakernel, dim3(grid_blocks), dim3(NTHREADS), args, LDS_BYTES, stream);
    if (e != hipSuccess) fprintf(stderr, "cooperative launch failed: %s (grid %d)\n", hipGetErrorString(e), grid_blocks);
}
```

```cpp
#include <hip/hip_runtime.h>
#include <hip/hip_cooperative_groups.h>
#include <cstdio>
#include <cstdint>
namespace cg = cooperative_groups;
namespace pg8 {
#define PG8_LAS __attribute__((address_space(3)))
typedef unsigned short bf16_t;
typedef short bf16x8 __attribute__((ext_vector_type(8)));
typedef float f32x4 __attribute__((ext_vector_type(4)));
typedef unsigned u32x4 __attribute__((ext_vector_type(4)));
constexpr int BM = 256, BK = 64, HALF = 128, HTB = HALF * BK * 2  , STAGE_BYTES = 8 * HTB, NXCD = 8, WGM = 8;

__host__ __device__ __forceinline__ int lds_byte(int r, int c) { const int st = (r >> 4) * 2 + (c >> 5), rr = r & 15, cc = c & 31, ob = rr * 64 + cc * 2; return st * 1024 + (ob ^ (((ob >> 9) & 1) << 5)); }
__host__ __device__ __forceinline__ void stage_rc(int b, int& R, int& C) { const int st = b / 1024, sb = b % 1024, swz = sb ^ (((sb >> 9) & 1) << 5); R = (st >> 1) * 16 + swz / 64; C = (st & 1) * 32 + (swz % 64) / 2; }
__host__ __device__ __forceinline__ int perm32(int rho) { const int n = rho >> 4, i = rho & 15; return 8 * (i >> 2) + 4 * n + (i & 3); }

struct Unit { int pm, pn, kt0, ntu; };
struct Gemm { const bf16_t* A; const bf16_t* Bt; int M, N, K; };

struct StaticOrder {
    int nM, nN, nwg, G, c, ntK, nsplit;
    __host__ __device__ void init(int M, int N, int K, int G_, int c_, int split) { nM = M / BM; nN = N / BM; G = G_; c = c_; ntK = K / BK; nsplit = 0; if (split) { nM -= 1; nsplit = ntK / 2; } nwg = nM * nN; }
    __host__ __device__ __forceinline__ bool next(int i, Unit& u) const {
        const long L = (long)i * G + c;
        int pm, pn, kt0, ntu; bool ok;
        if (L >= nwg) { const int idx = (int)(L - nwg); ok = idx < nN * nsplit; pn = idx % nN; pm = nM; kt0 = 2 * (idx / nN); ntu = 2; }
        else {
            int wgid = (int)L; { const int q = nwg / NXCD, r = nwg % NXCD, xcd = wgid % NXCD, off = wgid / NXCD; wgid = (xcd < r ? xcd * (q + 1) : r * (q + 1) + (xcd - r) * q) + off; }
            const int nig = WGM * nN, gid = wgid / nig, fm = gid * WGM, gsz = (nM - fm) < WGM ? (nM - fm) : WGM;
            pm = fm + ((wgid % nig) % gsz); pn = (wgid % nig) / gsz; kt0 = 0; ntu = ntK; ok = true;
        }
        u.pm = pm; u.pn = pn; u.kt0 = kt0; u.ntu = ntu; return ok;
    }
    __device__ __forceinline__ void a_ready(const Unit&) const {}
    __device__ __forceinline__ void done(const Unit&) const {}
};

__device__ __forceinline__ unsigned cvt_pk_bf16(float lo, float hi) { unsigned r; asm volatile("v_cvt_pk_bf16_f32 %0, %1, %2" : "=v"(r) : "v"(lo), "v"(hi)); return r; }
template <class Epi, class Sched, bool ALIGN_EPI = false, bool SP2 = false>
__device__ __forceinline__ void gemm_phase(PG8_LAS unsigned char* lds, const Gemm g, const Sched& S, const Epi& E) {
    int tid_o = threadIdx.x; asm volatile("" : "+v"(tid_o));
    const int tid = tid_o, wid = __builtin_amdgcn_readfirstlane(tid >> 6), lane = tid & 63, wr = wid >> 2, wc = wid & 3, fr = lane & 15, fq = lane >> 4;
    const int K = g.K, nt = K / BK;
    unsigned voffA[2], voffB[2];
#pragma unroll
    for (int i = 0; i < 2; ++i) { int R, C; stage_rc(tid * 16 + i * 8192, R, C); const int Rb = Epi::PERM ? ((R & ~31) + perm32(R & 31)) : R;
        voffA[i] = (unsigned)(R * K + C) * 2u; voffB[i] = (unsigned)(Rb * K + C) * 2u; }
    const size_t kstep = (size_t)(BK * 2);
    const size_t hstep = (size_t)HALF * K * 2;
    const size_t tstep = 2 * hstep;
    const unsigned ldsw = (unsigned)wid * 1024u;
    const int aoff = lds_byte(wr * 64 + fr, fq * 8), boff = lds_byte(wc * 32 + fr, fq * 8);
#define PG8_SA(b, h) (((b) * 2 + (h)) * HTB)
#define PG8_SB(b, h) ((4 + (b) * 2 + (h)) * HTB)
#define PG8_STAGE(bufoff, gbase, voff) do { _Pragma("unroll") for (int _i = 0; _i < 2; ++_i) \
        __builtin_amdgcn_global_load_lds((const unsigned*)((const char*)(gbase) + (voff)[_i]), (PG8_LAS unsigned*)(lds + (bufoff) + ldsw + _i * 8192), 16, 0, 0); } while (0)
#define PG8_LDA(dst, b, h) do { _Pragma("unroll") for (int m = 0; m < 4; ++m) _Pragma("unroll") for (int k = 0; k < 2; ++k) dst[m][k] = *(const PG8_LAS bf16x8*)(lds + PG8_SA(b, h) + aoff + m * 2048 + k * 1024); } while (0)
#define PG8_LDB(dst, b, h) do { _Pragma("unroll") for (int n = 0; n < 2; ++n) _Pragma("unroll") for (int k = 0; k < 2; ++k) dst[n][k] = *(const PG8_LAS bf16x8*)(lds + PG8_SB(b, h) + boff + n * 2048 + k * 1024); } while (0)
#define PG8_MMA(ai, bj, At, Bt) do { __builtin_amdgcn_s_setprio(1); _Pragma("unroll") for (int m = 0; m < 4; ++m) _Pragma("unroll") for (int n = 0; n < 2; ++n) _Pragma("unroll") for (int k = 0; k < 2; ++k) \
        acc[ai][bj][m][n] = __builtin_amdgcn_mfma_f32_16x16x32_bf16(Bt[n][k], At[m][k], acc[ai][bj][m][n], 0, 0, 0); __builtin_amdgcn_s_setprio(0); } while (0)
#define PG8_WAIT_V(n) asm volatile("s_waitcnt vmcnt(" #n ")" ::: "memory")
#define PG8_WAIT_L(n) asm volatile("s_waitcnt lgkmcnt(" #n ")" ::: "memory")
#define PG8_BAR __builtin_amdgcn_s_barrier()
#define PG8_SCHED __builtin_amdgcn_sched_barrier(0)
    Unit cur, nxt; int ui = 0;
    if (!S.next(0, cur)) return;
    f32x4 acc[2][2][4][2];
#pragma unroll
    for (int a = 0; a < 2; ++a)
#pragma unroll
        for (int b = 0; b < 2; ++b)
#pragma unroll
            for (int m = 0; m < 4; ++m)
#pragma unroll
                for (int n = 0; n < 2; ++n) acc[a][b][m][n] = (f32x4){0.f, 0.f, 0.f, 0.f};
    bf16x8 At[4][2], B0[2][2], B1[2][2];
    const char* cA = (const char*)g.A + (size_t)cur.pm * tstep + (size_t)cur.kt0 * kstep; const char* cB = (const char*)g.Bt + (size_t)cur.pn * tstep + (size_t)cur.kt0 * kstep;
    S.a_ready(cur);
    if constexpr (SP2) {
        PG8_STAGE(PG8_SB(0, 0), cB, voffB); PG8_STAGE(PG8_SB(0, 1), cB + hstep, voffB); PG8_STAGE(PG8_SA(0, 0), cA, voffA); PG8_STAGE(PG8_SA(0, 1), cA + hstep, voffA);
        if (wr == 1) PG8_BAR;
        PG8_WAIT_V(2); PG8_BAR;
        PG8_STAGE(PG8_SB(1, 0), cB + kstep, voffB); PG8_STAGE(PG8_SA(1, 0), cA + kstep, voffA); PG8_STAGE(PG8_SB(1, 1), cB + hstep + kstep, voffB);
        PG8_WAIT_V(6); PG8_BAR;
    } else {
        PG8_STAGE(PG8_SB(0, 0), cB, voffB); PG8_STAGE(PG8_SA(0, 0), cA, voffA); PG8_STAGE(PG8_SB(0, 1), cB + hstep, voffB); PG8_STAGE(PG8_SA(0, 1), cA + hstep, voffA);
        if (wr == 1) PG8_BAR;
        PG8_WAIT_V(4); PG8_BAR;
        PG8_STAGE(PG8_SB(1, 0), cB + kstep, voffB); PG8_STAGE(PG8_SA(1, 0), cA + kstep, voffA); PG8_STAGE(PG8_SB(1, 1), cB + hstep + kstep, voffB);
        PG8_WAIT_V(6); PG8_BAR;
    }
    for (;;) {
        const bool has_next = S.next(ui + 1, nxt);
        const char* nA = has_next ? (const char*)g.A + (size_t)nxt.pm * tstep + (size_t)nxt.kt0 * kstep : cA; const char* nB = has_next ? (const char*)g.Bt + (size_t)nxt.pn * tstep + (size_t)nxt.kt0 * kstep : cB;
        const int ntc = cur.ntu;
        for (int t = 0; t < ntc; t += 2) {
            const bool last = (t == ntc - 2);
            const char* a1 = cA + (size_t)(t + 1) * kstep;
            const char* a2 = last ? nA : cA + (size_t)(t + 2) * kstep; const char* b2 = last ? nB : cB + (size_t)(t + 2) * kstep;
            const char* a3 = a2 + kstep; const char* b3 = b2 + kstep;
            if (last && has_next) S.a_ready(nxt);
            if constexpr (SP2) {
            PG8_LDB(B0, 0, 0); PG8_LDB(B1, 0, 1); PG8_SCHED; PG8_LDA(At, 0, 0); PG8_STAGE(PG8_SA(1, 1), a1 + hstep, voffA);
            PG8_WAIT_V(8); PG8_WAIT_L(0); PG8_BAR; PG8_MMA(0, 0, At, B0); PG8_MMA(0, 1, At, B1); PG8_BAR; PG8_SCHED;
            PG8_LDA(At, 0, 1); PG8_STAGE(PG8_SB(0, 0), b2, voffB); PG8_STAGE(PG8_SB(0, 1), b2 + hstep, voffB); PG8_STAGE(PG8_SA(0, 0), a2, voffA);
            PG8_WAIT_V(8); PG8_WAIT_L(0); PG8_BAR; PG8_MMA(1, 0, At, B0); PG8_MMA(1, 1, At, B1); PG8_BAR; PG8_SCHED;
            PG8_LDB(B0, 1, 0); PG8_LDB(B1, 1, 1); PG8_SCHED; PG8_LDA(At, 1, 0); PG8_STAGE(PG8_SA(0, 1), a2 + hstep, voffA);
            PG8_WAIT_V(8); PG8_WAIT_L(0); PG8_BAR; PG8_MMA(0, 0, At, B0); PG8_MMA(0, 1, At, B1); PG8_BAR; PG8_SCHED;
            PG8_LDA(At, 1, 1); PG8_STAGE(PG8_SB(1, 0), b3, voffB); PG8_STAGE(PG8_SB(1, 1), b3 + hstep, voffB); PG8_STAGE(PG8_SA(1, 0), a3, voffA);
            PG8_WAIT_V(8); PG8_WAIT_L(0); PG8_BAR; PG8_MMA(1, 0, At, B0); PG8_MMA(1, 1, At, B1); PG8_BAR; PG8_SCHED;
            } else {
            PG8_LDB(B0, 0, 0); PG8_SCHED; PG8_LDA(At, 0, 0); PG8_STAGE(PG8_SA(1, 1), a1 + hstep, voffA);
            PG8_WAIT_L(8); PG8_BAR; PG8_WAIT_L(0); PG8_MMA(0, 0, At, B0); PG8_BAR; PG8_SCHED;
            PG8_LDB(B1, 0, 1); PG8_STAGE(PG8_SB(0, 0), b2, voffB);
            PG8_BAR; PG8_WAIT_L(0); PG8_MMA(0, 1, At, B1); PG8_BAR;
            PG8_LDA(At, 0, 1); PG8_STAGE(PG8_SA(0, 0), a2, voffA);
            PG8_BAR; PG8_WAIT_L(0); PG8_MMA(1, 0, At, B0); PG8_BAR; PG8_SCHED;
            PG8_STAGE(PG8_SB(0, 1), b2 + hstep, voffB);
            PG8_WAIT_V(6); PG8_BAR; PG8_MMA(1, 1, At, B1); PG8_BAR;
            PG8_LDB(B0, 1, 0); PG8_SCHED; PG8_LDA(At, 1, 0); PG8_STAGE(PG8_SA(0, 1), a2 + hstep, voffA);
            PG8_WAIT_L(8); PG8_BAR; PG8_WAIT_L(0); PG8_MMA(0, 0, At, B0); PG8_BAR; PG8_SCHED;
            PG8_LDB(B1, 1, 1); PG8_STAGE(PG8_SB(1, 0), b3, voffB);
            PG8_BAR; PG8_WAIT_L(0); PG8_MMA(0, 1, At, B1); PG8_BAR;
            PG8_LDA(At, 1, 1); PG8_STAGE(PG8_SA(1, 0), a3, voffA);
            PG8_BAR; PG8_WAIT_L(0); PG8_MMA(1, 0, At, B0); PG8_BAR; PG8_SCHED;
            PG8_STAGE(PG8_SB(1, 1), b3 + hstep, voffB);
            PG8_WAIT_V(6); PG8_BAR; PG8_MMA(1, 1, At, B1); PG8_BAR;
            }
        }
        if constexpr (ALIGN_EPI) { if (wr == 0) PG8_BAR; }
        if constexpr (!Epi::AFTER_DRAIN) { E(acc, cur, wr, wc, fr, fq); S.done(cur); }
        if (!has_next) break;
#pragma unroll
        for (int a = 0; a < 2; ++a)
#pragma unroll
            for (int b = 0; b < 2; ++b)
#pragma unroll
                for (int m = 0; m < 4; ++m)
#pragma unroll
                    for (int n = 0; n < 2; ++n) acc[a][b][m][n] = (f32x4){0.f, 0.f, 0.f, 0.f};
        cur = nxt; cA = nA; cB = nB; ++ui;
        if constexpr (ALIGN_EPI) { if (wr == 1) PG8_BAR; }
    }
    PG8_WAIT_V(0);
    if constexpr (!ALIGN_EPI) { if (wr == 0) PG8_BAR; }
    PG8_BAR;
    if constexpr (Epi::AFTER_DRAIN) { E.fused(acc, cur, wr, wc, fr, fq, lds, wid, lane); S.done(cur); }
#undef PG8_SA
#undef PG8_SB
#undef PG8_STAGE
#undef PG8_LDA
#undef PG8_LDB
#undef PG8_MMA
#undef PG8_WAIT_V
#undef PG8_WAIT_L
#undef PG8_BAR
#undef PG8_SCHED
}
}

#define LAS __attribute__((address_space(3)))
typedef unsigned short bf16;
typedef short bf16x8 __attribute__((ext_vector_type(8)));
typedef float f32x4 __attribute__((ext_vector_type(4)));
typedef float f32x16 __attribute__((ext_vector_type(16)));
typedef unsigned u32x4 __attribute__((ext_vector_type(4)));
typedef unsigned u32x2 __attribute__((ext_vector_type(2)));
typedef float f32x2 __attribute__((ext_vector_type(2)));

constexpr int T_ = 16384, L_ = 256, MT_ = 16640, D_ = 1024, F_ = 2816;
constexpr int NTHREADS = 512, NWAVES = 8;
constexpr int LDS_BYTES = 131072 + 512;
constexpr int VCU_OFF = 131072 + 496;
constexpr int PARAM_OFF = 131072 + 256;
constexpr size_t MiB = 1u << 20;
constexpr size_t WS_MODS = 0, WS_XC = 1 * MiB, WS_WM = 2 * MiB, WS_WF = 18 * MiB, WS_HX = 35 * MiB, WS_R = 68 * MiB;
constexpr size_t WS_Y1 = WS_R, WS_Y2 = WS_R + 33 * MiB;
constexpr size_t WS_H = WS_R;
constexpr size_t WS_RQ = WS_R, WS_RK = WS_R + 33 * MiB, WS_RG = WS_R + 66 * MiB, WS_RKT = WS_R + 131 * MiB, WS_RVT = WS_R + 164 * MiB,
                 WS_ROI = WS_R + 229 * MiB, WS_ROIC = WS_R + 293 * MiB, WS_END = WS_R + 300 * MiB;
constexpr size_t WS_AQ = WS_R, WS_AK = WS_R + 33 * MiB, WS_AVT = WS_R + 42 * MiB, WS_AO = WS_R + 66 * MiB;
static_assert(WS_END <= 384 * MiB, "ws");
constexpr size_t WS_BAR = 512 * 1024;

struct Params { const float* in[25]; float* out; unsigned char* ws; };
__device__ __forceinline__ int rfl_i(int v) { return __builtin_amdgcn_readfirstlane(v); }
template <class P> __device__ __forceinline__ P rfl_p(P v) { const unsigned long long x = (unsigned long long)v; const unsigned lo = __builtin_amdgcn_readfirstlane((unsigned)x), hi = __builtin_amdgcn_readfirstlane((unsigned)(x >> 32)); return (P)(((unsigned long long)hi << 32) | lo); }
template <class T> __device__ __forceinline__ T* as_global(T* p) { return (T*)(__attribute__((address_space(1))) T*)(unsigned long long)p; }
struct LP {
    const LAS unsigned long long* q;
    __device__ __forceinline__ const float* in(int i) const { return as_global((const float*)rfl_p(q[i])); }
    __device__ __forceinline__ float* out() const { return as_global((float*)rfl_p(q[25])); }
    __device__ __forceinline__ unsigned char* ws() const { return as_global((unsigned char*)rfl_p(q[26])); }
};

__device__ __forceinline__ int otid() { int t = threadIdx.x; asm volatile("" : "+v"(t)); return t; }
__device__ __forceinline__ size_t tr_off(int row, int tok, int NR) { return ((size_t)(tok >> 7) * NR + row) * 128 + (tok & 127); }
__device__ __forceinline__ size_t kt_off(int row, int tok) { const int h = row >> 8, d = row & 255, t = tok & 127;
    return ((((size_t)(tok >> 7) * 4 + h) * 8 + (d >> 5)) * 8 + (t >> 4)) * 512 + ((((t >> 3) & 1) * 32 + (d & 31)) * 8) + (t & 7); }
__device__ __forceinline__ size_t q_off(int row, int h, int sd) { const int t = row & 127;
    return ((((size_t)(row >> 7) * 4 + h) * 8 + (t >> 4)) * 8 + (sd >> 5)) * 512 + ((((sd >> 3) & 3) * 16 + (t & 15)) * 8) + (sd & 7); }
__device__ __forceinline__ float bf2f(unsigned short u) { return __uint_as_float(((unsigned)u) << 16); }
typedef __bf16 bf16x2_t __attribute__((ext_vector_type(2)));
__device__ __forceinline__ unsigned pk2(float lo, float hi) { const f32x2 v = {lo, hi}; const bf16x2_t b = __builtin_convertvector(v, bf16x2_t); return __builtin_bit_cast(unsigned, b); }
__device__ __forceinline__ float silu_f(float x) { return x / (1.0f + __expf(-x)); }
__device__ __forceinline__ float sigmoid_f(float x) { return 1.0f / (1.0f + __expf(-x)); }
__device__ __forceinline__ void st4bf(bf16* p, f32x4 v) { u32x2 w; w.x = pk2(v[0], v[1]); w.y = pk2(v[2], v[3]); *(u32x2*)p = w; }
__device__ __forceinline__ float wave_sum(float v) {
#pragma unroll
    for (int o = 1; o < 64; o <<= 1) v += __shfl_xor(v, o);
    return v;
}

#ifndef EPI_MASK
#define EPI_MASK 0x7f
#endif
#define EPI_ON(m) ((EPI_MASK >> (m)) & 1)
enum { EM_GLU = 0, EM_SWIGLU = 1, EM_RES = 2, EM_RET = 3, EM_RETT = 4, EM_ATT = 5, EM_PLAIN = 6 };
struct EpiD {
    int mode, ldc, M, N, K, pad;
    const bf16* A; const bf16* Bt;
    bf16* o0; bf16* o1; bf16* o2;
    const float* bias; const float* baseL; const float* baseC; float* outL; float* outC;
    const float* gateL; const float* gateC; const float* gq; const float* gk;
    float* part;
};
constexpr int DESC_OFF = 131072;
struct Epi {
    static constexpr bool PERM = false, AFTER_DRAIN = false;
    const LAS EpiD* d;
    __device__ __forceinline__ void operator()(const f32x4 (&acc)[2][2][4][2], const pg8::Unit& u, int wr_, int wc_, int fr_, int fq_) const {
        const int mode = rfl_i(d->mode);
        using namespace pg8;
        int wr = wr_, wc = wc_, fr = fr_, fq = fq_;
        asm volatile("" : "+v"(fr), "+v"(fq)); asm volatile("" : "+s"(wr), "+s"(wc));
        const int rowb = u.pm * BM + wr * 64 + fr;
        const int colb = u.pn * BM + wc * 32 + 4 * fq;
        if ((EPI_ON(EM_GLU) && mode == EM_GLU) || (EPI_ON(EM_SWIGLU) && mode == EM_SWIGLU)) {
            const int ch = u.pn * 128 + wc * 32 + 4 * fq;
            bf16* const o0 = as_global(d->o0); const float* const bias = as_global(d->bias); const int ldc = d->ldc;
            f32x4 ba[2], bg[2];
#pragma unroll
            for (int n = 0; n < 2; ++n) {
                if (mode == EM_GLU) { ba[n] = *(const f32x4*)(bias + ch + 16 * n); bg[n] = *(const f32x4*)(bias + 1024 + ch + 16 * n); }
                else { ba[n] = (f32x4){0.f, 0.f, 0.f, 0.f}; bg[n] = ba[n]; }
            }
#pragma unroll
            for (int ai = 0; ai < 2; ++ai)
#pragma unroll
                for (int m = 0; m < 4; ++m) {
                    bf16* rp = o0 + (size_t)(rowb + ai * HALF + m * 16) * ldc + ch;
#pragma unroll
                    for (int n = 0; n < 2; ++n) {
                        const f32x4 a = acc[ai][0][m][n] + ba[n], g = acc[ai][1][m][n] + bg[n];
                        f32x4 v;
                        if (mode == EM_GLU) { v[0] = a[0] * sigmoid_f(g[0]); v[1] = a[1] * sigmoid_f(g[1]); v[2] = a[2] * sigmoid_f(g[2]); v[3] = a[3] * sigmoid_f(g[3]); }
                        else { v[0] = silu_f(a[0]) * g[0]; v[1] = silu_f(a[1]) * g[1]; v[2] = silu_f(a[2]) * g[2]; v[3] = silu_f(a[3]) * g[3]; }
                        st4bf(rp + 16 * n, v);
                    }
                }
        } else if (EPI_ON(EM_RES) && mode == EM_RES) {
            const bool isc = (u.pm >= T_ / BM);
            const float* gt = isc ? as_global(d->gateC) : as_global(d->gateL);
            f32x4 gv[2][2];
#pragma unroll
            for (int bj = 0; bj < 2; ++bj)
#pragma unroll
                for (int n = 0; n < 2; ++n) gv[bj][n] = *(const f32x4*)(gt + colb + bj * HALF + 16 * n);
            const float* bs = isc ? as_global(d->baseC) : as_global(d->baseL); float* ot = isc ? as_global(d->outC) : as_global(d->outL);
            const int rsub = isc ? T_ : 0;
#pragma unroll
            for (int ai = 0; ai < 2; ++ai)
#pragma unroll
                for (int m = 0; m < 4; ++m) {
                    const size_t off = (size_t)(rowb + ai * HALF + m * 16 - rsub) * D_ + colb;
#pragma unroll
                    for (int bj = 0; bj < 2; ++bj)
#pragma unroll
                        for (int n = 0; n < 2; ++n) {
                            if (isc) {
                                *(f32x4*)(as_global(d->part) + (size_t)(u.kt0 >> 1) * (L_ * D_) + off + bj * HALF + 16 * n) = gv[bj][n] * acc[ai][bj][m][n];
                            } else {
                                const f32x4 b = *(const f32x4*)(bs + off + bj * HALF + 16 * n);
                                *(f32x4*)(ot + off + bj * HALF + 16 * n) = b + gv[bj][n] * acc[ai][bj][m][n];
                            }
                        }
                }
        } else if (EPI_ON(EM_RET) && mode == EM_RET) {
            bf16* const o0 = as_global(d->o0); bf16* const o1 = as_global(d->o1); bf16* const o2 = as_global(d->o2);
            if (u.pn >= 4 && u.pn < 12) {
                const int cg0 = (u.pn - 4) * BM + wc * 32 + 4 * fq;
#pragma unroll
                for (int ai = 0; ai < 2; ++ai)
#pragma unroll
                    for (int m = 0; m < 4; ++m) {
                        bf16* rp = o1 + (size_t)(rowb + ai * HALF + m * 16) * 2048 + cg0;
#pragma unroll
                        for (int bj = 0; bj < 2; ++bj)
#pragma unroll
                            for (int n = 0; n < 2; ++n) { const f32x4 a = acc[ai][bj][m][n]; f32x4 v; v[0] = silu_f(a[0]); v[1] = silu_f(a[1]); v[2] = silu_f(a[2]); v[3] = silu_f(a[3]); st4bf(rp + bj * HALF + 16 * n, v); }
                    }
            } else {
                const bool isk = u.pn >= 12; const int h = u.pn & 3; bf16* ob = isk ? o2 : o0; const float sc = isk ? 0.0625f : 1.0f;
                float inv[2][4];
#pragma unroll
                for (int n = 0; n < 2; ++n)
#pragma unroll
                    for (int e = 0; e < 4; ++e) { const int i = 32 * (wc & 1) + 16 * n + 4 * fq + e; inv[n][e] = exp2f(-(float)i * (13.287712379549449f / 64.0f)); }
                const int j0 = wc * 32 + 4 * fq;
#pragma unroll
                for (int ai = 0; ai < 2; ++ai)
#pragma unroll
                    for (int m = 0; m < 4; ++m) {
                        const int row = rowb + ai * HALF + m * 16;
                        const bool lat = row < T_;
                        const float pos = (float)((wc < 2) ? (row >> 6) : (row & 63));
                        bf16* rp = ob + (size_t)row * 1024 + 256 * h + j0;
#pragma unroll
                        for (int n = 0; n < 2; ++n) {
                            const f32x4 x1 = acc[ai][0][m][n], x2 = acc[ai][1][m][n]; f32x4 r1, r2;
#pragma unroll
                            for (int e = 0; e < 4; ++e) {
                                const float ang = pos * inv[n][e]; float c = __cosf(ang), s = __sinf(ang);
                                if (!lat) { c = 1.f; s = 0.f; }
                                r1[e] = (x1[e] * c - x2[e] * s) * sc; r2[e] = (x2[e] * c + x1[e] * s) * sc;
                            }
                            if (isk) { st4bf(rp + 16 * n, r1); st4bf(rp + 128 + 16 * n, r2); }
                            else { st4bf(ob + q_off(row, h, j0 + 16 * n), r1); st4bf(ob + q_off(row, h, j0 + 16 * n + 128), r2); }
                        }
                    }
            }
        } else if (EPI_ON(EM_RETT) && mode == EM_RETT) {
            bf16* const o0 = as_global(d->o0); bf16* const o1 = as_global(d->o1);
            if (u.pm >= 4) {
#pragma unroll
                for (int ai = 0; ai < 2; ++ai)
#pragma unroll
                    for (int m = 0; m < 4; ++m) {
                        const int vrow = rowb - 4 * BM + ai * HALF + m * 16;
#pragma unroll
                        for (int bj = 0; bj < 2; ++bj)
#pragma unroll
                            for (int n = 0; n < 2; ++n) st4bf(o1 + tr_off(vrow, colb + bj * HALF + 16 * n, 2048), acc[ai][bj][m][n]);
                    }
            } else {
                float inv[4];
#pragma unroll
                for (int m = 0; m < 4; ++m) { const int i = 16 * m + fr; inv[m] = exp2f(-(float)i * (13.287712379549449f / 64.0f)); }
#pragma unroll
                for (int bj = 0; bj < 2; ++bj)
#pragma unroll
                    for (int n = 0; n < 2; ++n) {
                        const int tok0 = colb + bj * HALF + 16 * n;
                        const bool lat = tok0 < T_;
#pragma unroll
                        for (int m = 0; m < 4; ++m) {
                            const f32x4 x1 = acc[0][bj][m][n], x2 = acc[1][bj][m][n]; f32x4 r1, r2;
#pragma unroll
                            for (int e = 0; e < 4; ++e) {
                                const int tok = tok0 + e;
                                const float pos = (float)((wr == 0) ? (tok >> 6) : (tok & 63));
                                const float ang = pos * inv[m]; float c = __cosf(ang), s = __sinf(ang);
                                if (!lat) { c = 1.f; s = 0.f; }
                                r1[e] = (x1[e] * c - x2[e] * s) * 0.0625f; r2[e] = (x2[e] * c + x1[e] * s) * 0.0625f;
                            }
                            const int row = u.pm * BM + wr * 64 + m * 16 + fr;
                            st4bf(o0 + kt_off(row, tok0), r1); st4bf(o0 + kt_off(row + 128, tok0), r2);
                        }
                    }
            }
        } else if (EPI_ON(EM_ATT) && mode == EM_ATT) {
            bf16* const o0 = as_global(d->o0); bf16* const o1 = as_global(d->o1);
            const bool isk = u.pn >= 4; const float* gn = isk ? as_global(d->gk) : as_global(d->gq);
            f32x4 gv[2][2];
#pragma unroll
            for (int bj = 0; bj < 2; ++bj)
#pragma unroll
                for (int n = 0; n < 2; ++n) gv[bj][n] = *(const f32x4*)(gn + 32 * n + 16 * bj + 4 * fq);
            float inv[4];
#pragma unroll
            for (int e = 0; e < 4; ++e) { const int i = 4 * fq + e; inv[e] = exp2f(-(float)i * (13.287712379549449f / 16.0f)); }
            const float sc = isk ? 1.0f : 0.125f;
            bf16* ob = isk ? o1 : o0; const int ld = isk ? 256 : 1024;
            const int cb = (isk ? 0 : u.pn * BM) + 64 * wc + 4 * fq;
#pragma unroll
            for (int ai = 0; ai < 2; ++ai)
#pragma unroll
                for (int m = 0; m < 4; ++m) {
                    const int row = rowb + ai * HALF + m * 16;
                    const bool lat = row < T_;
                    float ss = 0.f;
#pragma unroll
                    for (int bj = 0; bj < 2; ++bj)
#pragma unroll
                        for (int n = 0; n < 2; ++n) { const f32x4 a = acc[ai][bj][m][n]; ss += (a[0] * a[0] + a[1] * a[1]) + (a[2] * a[2] + a[3] * a[3]); }
                    ss += __shfl_xor(ss, 16); ss += __shfl_xor(ss, 32);
                    const float rstd = rsqrtf(ss * (1.0f / 64.0f) + 1e-6f);
                    bf16* rp = ob + (size_t)row * ld + cb;
#pragma unroll
                    for (int n = 0; n < 2; ++n) {
                        const float pos = (float)((n == 0) ? (row >> 6) : (row & 63));
                        const f32x4 y1 = acc[ai][0][m][n] * rstd * gv[0][n], y2 = acc[ai][1][m][n] * rstd * gv[1][n]; f32x4 r1, r2;
#pragma unroll
                        for (int e = 0; e < 4; ++e) {
                            const float ang = pos * inv[e]; float c = __cosf(ang), s = __sinf(ang);
                            if (!lat) { c = 1.f; s = 0.f; }
                            r1[e] = (y1[e] * c - y2[e] * s) * sc; r2[e] = (y2[e] * c + y1[e] * s) * sc;
                        }
                        st4bf(rp + 16 * n, r1); st4bf(rp + 32 + 16 * n, r2);
                    }
                }
        } else if (EPI_ON(EM_PLAIN)) {
            bf16* const o0 = as_global(d->o0); const int ldc = d->ldc;
#pragma unroll
            for (int ai = 0; ai < 2; ++ai)
#pragma unroll
                for (int m = 0; m < 4; ++m) {
                    const int vrow = rowb + ai * HALF + m * 16;
#pragma unroll
                    for (int bj = 0; bj < 2; ++bj)
#pragma unroll
                        for (int n = 0; n < 2; ++n) st4bf(o0 + tr_off(vrow, colb + bj * HALF + 16 * n, ldc), acc[ai][bj][m][n]);
                }
        }
    }
};

__device__ __forceinline__ void run_gemm(LAS unsigned char* lds) {
    const LAS EpiD* d = (const LAS EpiD*)(lds + DESC_OFF);
    const int M = rfl_i(d->M), N = rfl_i(d->N), K = rfl_i(d->K);
    pg8::Gemm g{as_global(rfl_p(d->A)), as_global(rfl_p(d->Bt)), M, N, K}; pg8::StaticOrder S; const int md = rfl_i(d->mode); const int G = (int)gridDim.x;
    const int vcu = rfl_i(*(volatile LAS int*)(lds + VCU_OFF));
    const int cb = (md == EM_RETT || md == EM_PLAIN) ? (int)(((unsigned)vcu + (unsigned)G / 2u) % (unsigned)G) : vcu;
    S.init(M, N, K, G, cb, (md == EM_RES && M == MT_) ? 1 : 0);
    Epi E; E.d = d;
#ifndef NO_GEMM
    pg8::gemm_phase<Epi, pg8::StaticOrder, true, true>(lds, g, S, E);
#endif
    __syncthreads();
}

__device__ __forceinline__ int dest_row(int kind, int n, int N) {
    if (kind == 1) { const int half = N >> 1; if (n < half) return ((n >> 7) << 8) + (n & 127); const int q = n - half; return ((q >> 7) << 8) + 128 + (q & 127); }
    if (kind == 2) {
        if (n < 2048) { const int isk = n >> 10, hn = n & 1023, h = hn >> 8, d = hn & 255, bj = (d >> 6) & 1, j = (d & 63) + ((d >> 7) << 6); return (isk ? 3072 : 0) + 256 * h + 128 * bj + j; }
        if (n < 4096) return 4096 + (n - 2048);
        return 1024 + (n - 4096);
    }
    if (kind == 3) {
        if (n < 1280) { const int isk = n >= 1024; const int hn = isk ? n - 1024 : n; const int head = hn >> 6, d = hn & 63, bj = (d >> 4) & 1, nn = d >> 5, jj = d & 15;
            const int pn = isk ? 4 : (head >> 2), wc = head & 3; return 256 * pn + 128 * bj + 32 * wc + 16 * nn + jj; }
        return n;
    }
    return n;
}
__device__ __forceinline__ void convert_matrix(const float* W, int K, int N, bf16* WT, int kind, LAS float* scr, int gw, int NGW, int lane) {
    const int nblk = N / 32, nitems = (K / 64) * nblk;
    for (int item = gw; item < nitems; item += NGW) {
        const int kb = item / nblk, nb = item % nblk, k0 = 64 * kb, n0 = 32 * nb;
        float wreg[32];
#pragma unroll
        for (int i = 0; i < 32; ++i) { const int kk = 2 * i + (lane >> 5); wreg[i] = __builtin_nontemporal_load(W + (size_t)(k0 + kk) * N + n0 + (lane & 31)); }
        __builtin_amdgcn_sched_barrier(0);
#pragma unroll
        for (int i = 0; i < 32; ++i) { const int kk = 2 * i + (lane >> 5); scr[kk * 33 + (lane & 31)] = wreg[i]; }
        asm volatile("s_waitcnt lgkmcnt(0)" ::: "memory");
        const int c = lane & 7;
#pragma unroll
        for (int j = 0; j < 4; ++j) { const int n = (lane >> 3) + 8 * j; const LAS float* s = scr + (8 * c) * 33 + n;
            u32x4 o; o.x = pk2(s[0 * 33], s[1 * 33]); o.y = pk2(s[2 * 33], s[3 * 33]); o.z = pk2(s[4 * 33], s[5 * 33]); o.w = pk2(s[6 * 33], s[7 * 33]);
            *(u32x4*)(WT + (size_t)dest_row(kind, n0 + n, N) * K + k0 + 8 * c) = o; }
        asm volatile("s_waitcnt lgkmcnt(0)" ::: "memory");
    }
}
__device__ __forceinline__ void convert_mixer(const LP& p, int l, LAS unsigned char* lds, int bidx, int nblk) {
    const int tid = otid(), lane = tid & 63, wave = tid >> 6; const int gw = bidx * NWAVES + wave, NGW = nblk * NWAVES;
    LAS float* scr = (LAS float*)(lds + wave * 8704);
    bf16* wm = (bf16*)(p.ws() + WS_WM);
    const int kind = l % 3, j = l / 3;
    if (kind == 0) {
        convert_matrix(p.in(8) + (size_t)j * 1024 * 2048, 1024, 2048, wm, 1, scr, gw, NGW, lane);
        convert_matrix(p.in(13) + (size_t)j * 1024 * 1024, 1024, 1024, wm + 4 * MiB / 2, 0, scr, gw, NGW, lane);
    } else if (kind == 1) {
        convert_matrix(p.in(14) + (size_t)j * 1024 * 6144, 1024, 6144, wm, 2, scr, gw, NGW, lane);
        convert_matrix(p.in(17) + (size_t)j * 2048 * 1024, 2048, 1024, wm + 12 * MiB / 2, 0, scr, gw, NGW, lane);
    } else {
        convert_matrix(p.in(18) + (size_t)j * 1024 * 1536, 1024, 1536, wm, 3, scr, gw, NGW, lane);
        convert_matrix(p.in(22) + (size_t)j * 1024 * 1024, 1024, 1024, wm + 4 * MiB / 2, 0, scr, gw, NGW, lane);
    }
}
__device__ __forceinline__ void convert_ffn(const LP& p, int l, LAS unsigned char* lds, int bidx, int nblk) {
    const int tid = otid(), lane = tid & 63, wave = tid >> 6; const int gw = bidx * NWAVES + wave, NGW = nblk * NWAVES;
    LAS float* scr = (LAS float*)(lds + wave * 8704);
    bf16* wf = (bf16*)(p.ws() + WS_WF);
    convert_matrix(p.in(23) + (size_t)l * 1024 * 5632, 1024, 5632, wf, 1, scr, gw, NGW, lane);
    convert_matrix(p.in(24) + (size_t)l * 2816 * 1024, 2816, 1024, wf + 11 * MiB / 2, 0, scr, gw, NGW, lane);
}

constexpr size_t WS_ADAP = WS_R;
__device__ __forceinline__ void phase_adaln_partial(const LP& p) {
    const int tid = otid();
    float* part = (float*)(p.ws() + WS_ADAP);
    const float* c = p.in(1); const float* cc = p.in(3);
    for (int u = blockIdx.x; u < 256; u += gridDim.x) {
        const int l = u >> 6, k0 = (u & 63) * 16;
        const float* W = p.in(4) + (size_t)l * 1024 * 6144 + (size_t)k0 * 6144;
        f32x4 a0[3], a1[3];
#pragma unroll
        for (int q = 0; q < 3; ++q) { a0[q] = (f32x4){0.f, 0.f, 0.f, 0.f}; a1[q] = a0[q]; }
#pragma unroll
        for (int hb = 0; hb < 2; ++hb) {
            f32x4 wb[8][3]; float s0[8], s1[8];
#pragma unroll
            for (int kk = 0; kk < 8; ++kk) {
#pragma unroll
                for (int q = 0; q < 3; ++q) wb[kk][q] = __builtin_nontemporal_load((const f32x4*)(W + (size_t)(8 * hb + kk) * 6144 + 4 * tid + 2048 * q));
                s0[kk] = c[k0 + 8 * hb + kk]; s1[kk] = cc[k0 + 8 * hb + kk];
            }
            __builtin_amdgcn_sched_barrier(0);
#pragma unroll
            for (int kk = 0; kk < 8; ++kk) {
                const float t0 = silu_f(s0[kk]), t1 = silu_f(s1[kk]);
#pragma unroll
                for (int q = 0; q < 3; ++q) { a0[q] += wb[kk][q] * t0; a1[q] += wb[kk][q] * t1; }
            }
        }
#pragma unroll
        for (int q = 0; q < 3; ++q) { *(f32x4*)(part + (size_t)(u * 2 + 0) * 6144 + 4 * tid + 2048 * q) = a0[q]; *(f32x4*)(part + (size_t)(u * 2 + 1) * 6144 + 4 * tid + 2048 * q) = a1[q]; }
    }
}
__device__ __forceinline__ void phase_adaln_reduce(const LP& p) {
    const int tid = otid();
    const float* part = (const float*)(p.ws() + WS_ADAP); float* mods = (float*)(p.ws() + WS_MODS);
    for (int i = blockIdx.x * NTHREADS + tid; i < 4 * 2 * 6144 / 4; i += gridDim.x * NTHREADS) {
        const int l = i / (2 * 1536), r = i % (2 * 1536), sidx = r / 1536, c4 = r % 1536;
        f32x4 acc = *(const f32x4*)(p.in(5) + l * 6144 + 4 * c4);
#pragma unroll 8
        for (int kc = 0; kc < 64; ++kc) acc += *(const f32x4*)(part + (size_t)((l * 64 + kc) * 2 + sidx) * 6144 + 4 * c4);
        *(f32x4*)(mods + (size_t)(l * 2 + sidx) * 6144 + 4 * c4) = acc;
    }
}

__device__ __forceinline__ void phase_norm(const LP& p, int l, bool ffn, const float* xl, float* xc, const float* part, int nparts) {
    const int tid = otid(), lane = tid & 63, wave = tid >> 6; const int gw = blockIdx.x * NWAVES + wave, NGW = gridDim.x * NWAVES;
    const float* mods = (const float*)(p.ws() + WS_MODS);
    const float* g = (ffn ? p.in(7) : p.in(6)) + l * 1024;
    bf16* HX = (bf16*)(p.ws() + WS_HX);
    f32x4 gv[4];
#pragma unroll
    for (int j = 0; j < 4; ++j) gv[j] = *(const f32x4*)(g + 4 * lane + 256 * j);
    {
        const float* mb = mods + (size_t)(l * 2) * 6144 + (ffn ? 3072 : 0);
        f32x4 sh[4], sc[4], vn[4];
#pragma unroll
        for (int j = 0; j < 4; ++j) { sh[j] = *(const f32x4*)(mb + 4 * lane + 256 * j); sc[j] = *(const f32x4*)(mb + 1024 + 4 * lane + 256 * j) + 1.0f; }
        int m = gw;
        if (m < T_) {
#pragma unroll
            for (int j = 0; j < 4; ++j) vn[j] = *(const f32x4*)(xl + (size_t)m * 1024 + 4 * lane + 256 * j);
        }
        for (; m < T_; m += NGW) {
            f32x4 v[4]; float s = 0.f;
#pragma unroll
            for (int j = 0; j < 4; ++j) v[j] = vn[j];
            const int mn = m + NGW;
            if (mn < T_) {
#pragma unroll
                for (int j = 0; j < 4; ++j) vn[j] = *(const f32x4*)(xl + (size_t)mn * 1024 + 4 * lane + 256 * j);
            }
#pragma unroll
            for (int j = 0; j < 4; ++j) s += (v[j][0] * v[j][0] + v[j][1] * v[j][1]) + (v[j][2] * v[j][2] + v[j][3] * v[j][3]);
            const float rstd = rsqrtf(wave_sum(s) * (1.0f / 1024.0f) + 1e-6f);
#pragma unroll
            for (int j = 0; j < 4; ++j) st4bf(HX + (size_t)m * 1024 + 4 * lane + 256 * j, v[j] * rstd * gv[j] * sc[j] + sh[j]);
        }
    }
    for (int m = T_ + gw; m < MT_; m += NGW) {
        float* xr = xc + (size_t)(m - T_) * 1024;
        const float* mb = mods + (size_t)(l * 2 + 1) * 6144 + (ffn ? 3072 : 0);
        f32x4 v[4]; float s = 0.f;
#pragma unroll
        for (int j = 0; j < 4; ++j) v[j] = *(const f32x4*)(xr + 4 * lane + 256 * j);
        if (nparts > 0) {
            for (int sp0 = 0; sp0 < nparts; sp0 += 4) {
                f32x4 pb[4][4];
#pragma unroll
                for (int q = 0; q < 4; ++q) { const int sp = (sp0 + q < nparts) ? sp0 + q : sp0;
#pragma unroll
                    for (int j = 0; j < 4; ++j) pb[q][j] = *(const f32x4*)(part + (size_t)sp * (L_ * D_) + (size_t)(m - T_) * 1024 + 4 * lane + 256 * j); }
                __builtin_amdgcn_sched_barrier(0);
#pragma unroll
                for (int q = 0; q < 4; ++q) { if (sp0 + q < nparts) {
#pragma unroll
                    for (int j = 0; j < 4; ++j) v[j] += pb[q][j]; } }
            }
#pragma unroll
            for (int j = 0; j < 4; ++j) *(f32x4*)(xr + 4 * lane + 256 * j) = v[j];
        }
#pragma unroll
        for (int j = 0; j < 4; ++j) s += (v[j][0] * v[j][0] + v[j][1] * v[j][1]) + (v[j][2] * v[j][2] + v[j][3] * v[j][3]);
        const float rstd = rsqrtf(wave_sum(s) * (1.0f / 1024.0f) + 1e-6f);
#pragma unroll
        for (int j = 0; j < 4; ++j) {
            const f32x4 sh = *(const f32x4*)(mb + 4 * lane + 256 * j), sc = *(const f32x4*)(mb + 1024 + 4 * lane + 256 * j);
            st4bf(HX + (size_t)m * 1024 + 4 * lane + 256 * j, v[j] * rstd * gv[j] * (sc + 1.0f) + sh);
        }
    }
}

__device__ __forceinline__ void phase_dwconv(const LP& p, int j, int nunits, LAS unsigned char* lds) {
    const int tid = otid(), lane = tid & 63, wave = tid >> 6;
    const bf16* Y1 = (const bf16*)(p.ws() + WS_Y1); bf16* Y2 = (bf16*)(p.ws() + WS_Y2);
    const float* dw = p.in(10) + (size_t)j * 31 * 1024; const float* dwb = p.in(11) + j * 1024; const float* ng = p.in(12) + j * 1024;
    LAS float* tile = (LAS float*)lds;
    f32x2 wv[31];
#pragma unroll
    for (int w = 0; w < 31; ++w) wv[w] = *(const f32x2*)(dw + w * 1024 + 2 * tid);
    const f32x2 bb = *(const f32x2*)(dwb + 2 * tid);
    f32x4 gv[4];
#pragma unroll
    for (int q = 0; q < 4; ++q) gv[q] = *(const f32x4*)(ng + 4 * lane + 256 * q);
    for (int u = blockIdx.x; u < nunits; u += gridDim.x) {
        const int t0 = u * 16; const int lo = (t0 < T_) ? 0 : T_, hi = (t0 < T_) ? T_ : MT_;
        f32x2 av[16];
#pragma unroll
        for (int i = 0; i < 16; ++i) av[i] = bb;
        unsigned raws[46];
#pragma unroll
        for (int r = 0; r < 46; ++r) { const int row = t0 - 15 + r; const int rowc = (row >= lo && row < hi) ? row : t0; raws[r] = *(const unsigned*)(Y1 + (size_t)rowc * 1024 + 2 * tid); }
        __builtin_amdgcn_sched_barrier(0);
#pragma unroll
        for (int r = 0; r < 46; ++r) {
            const int row = t0 - 15 + r; const bool inr = (row >= lo && row < hi); const unsigned raw = raws[r];
            f32x2 vv; vv.x = inr ? __uint_as_float(raw << 16) : 0.f; vv.y = inr ? __uint_as_float(raw & 0xffff0000u) : 0.f;
#pragma unroll
            for (int i = 0; i < 16; ++i) { const int w = r - i; if (w >= 0 && w < 31) av[i] = __builtin_elementwise_fma(wv[w], vv, av[i]); }
        }
#pragma unroll
        for (int i = 0; i < 16; ++i) *(LAS f32x2*)(tile + i * 1024 + 2 * tid) = av[i];
        __syncthreads();
#pragma unroll
        for (int ii = 0; ii < 2; ++ii) {
            const int i = wave * 2 + ii;
            f32x4 v[4]; float s = 0.f;
#pragma unroll
            for (int q = 0; q < 4; ++q) { v[q] = *(const LAS f32x4*)(tile + i * 1024 + 4 * lane + 256 * q); s += (v[q][0] + v[q][1]) + (v[q][2] + v[q][3]); }
            const float mean = wave_sum(s) * (1.0f / 1024.0f); float s2 = 0.f;
#pragma unroll
            for (int q = 0; q < 4; ++q) { v[q] = v[q] - mean; s2 += (v[q][0] * v[q][0] + v[q][1] * v[q][1]) + (v[q][2] * v[q][2] + v[q][3] * v[q][3]); }
            const float rstd = rsqrtf(wave_sum(s2) * (1.0f / 1024.0f) + 1e-6f);
#pragma unroll
            for (int q = 0; q < 4; ++q) { f32x4 y = v[q] * rstd * gv[q]; y[0] = silu_f(y[0]); y[1] = silu_f(y[1]); y[2] = silu_f(y[2]); y[3] = silu_f(y[3]);
                st4bf(Y2 + (size_t)(t0 + i) * 1024 + 4 * lane + 256 * q, y); }
        }
        __syncthreads();
    }
}

__device__ __forceinline__ int crow(int r, int hi) { return (r & 3) + 8 * (r >> 2) + 4 * hi; }
__device__ __forceinline__ void phase_attn(const LP& p, int j, LAS unsigned char* lds) {
    const bf16* Q = (const bf16*)(p.ws() + WS_AQ); const bf16* K = (const bf16*)(p.ws() + WS_AK); const bf16* VT = (const bf16*)(p.ws() + WS_AVT); bf16* AO = (bf16*)(p.ws() + WS_AO);
    const float* sink = p.in(21) + j * 16;
    LAS unsigned char* Kl = lds; LAS unsigned char* Vl = lds + 3 * 18432;
    for (int u = blockIdx.x; u < 128 * 4; u += gridDim.x) {
        int tid = threadIdx.x; asm volatile("" : "+v"(tid));
        const int lane = tid & 63, wave = tid >> 6, l31 = lane & 31, hi = lane >> 5;
        const int blk = u >> 2, kh = u & 3; const int rb = 128 * blk;
        const int qh = 4 * kh + (wave >> 1); const int qoff = 64 * (wave & 1);
        bf16x8 qop[2][4];
#pragma unroll
        for (int qt = 0; qt < 2; ++qt)
#pragma unroll
            for (int ks = 0; ks < 4; ++ks) qop[qt][ks] = *(const bf16x8*)(Q + (size_t)(rb + qoff + 32 * qt + l31) * 1024 + 64 * qh + 16 * ks + 8 * hi);
        f32x16 o[2][2]; float lsum[2] = {0.f, 0.f};
#pragma unroll
        for (int a2 = 0; a2 < 2; ++a2)
#pragma unroll
            for (int b = 0; b < 2; ++b)
#pragma unroll
                for (int r = 0; r < 16; ++r) o[a2][b][r] = 0.f;
#pragma unroll 1
        for (int g = 0; g < 2; ++g) {
            if (g == 1 && blk >= 128) break;
            __syncthreads();
#pragma unroll 1
            for (int s3 = 0; s3 < 3 - g; ++s3) {
                const int kb = 3 * g + s3; int kr; bool valid = true;
                if (kb < 2) kr = T_ + 128 * kb; else { const int nb = blk + kb - 3; valid = (blk < 128) && nb >= 0 && nb <= 127; kr = 128 * nb; }
                if (!valid) continue;
                LAS unsigned char* Ks = Kl + s3 * 18432; LAS unsigned char* Vs = Vl + s3 * 17408;
                u32x4 kst2[2], vst2[2];
#pragma unroll
                for (int i = 0; i < 2; ++i) {
                    const int pid = tid + 512 * i;
                    { const int key = pid >> 3, pc = pid & 7; kst2[i] = *(const u32x4*)(K + (size_t)(kr + key) * 256 + 64 * kh + 8 * pc); }
                    { const int d = pid >> 4, pc = pid & 15; vst2[i] = *(const u32x4*)(VT + ((size_t)(kr >> 7) * 256 + 64 * kh + d) * 128 + 8 * pc); }
                }
                __builtin_amdgcn_sched_barrier(0);
#pragma unroll
                for (int i = 0; i < 2; ++i) {
                    const int pid = tid + 512 * i;
                    { const int key = pid >> 3, pc = pid & 7; *(LAS u32x4*)(Ks + key * 144 + 16 * pc) = kst2[i]; }
                    { const int d = pid >> 4, pc = pid & 15; *(LAS u32x4*)(Vs + d * 272 + 16 * pc) = vst2[i]; }
                }
            }
            __syncthreads();
#pragma unroll 1
            for (int s3 = 0; s3 < 3 - g; ++s3) {
                const int kb = 3 * g + s3; int type = 0; bool valid = true;
                if (kb >= 2) { const int nb = blk + kb - 3; valid = (blk < 128) && nb >= 0 && nb <= 127; type = (kb == 2) ? 1 : (kb == 4) ? 2 : 0; }
                if (!valid) continue;
                const LAS unsigned char* Ks = Kl + s3 * 18432; const LAS unsigned char* Vs = Vl + s3 * 17408;
                int l31m = l31, him = hi; asm volatile("" : "+v"(l31m), "+v"(him));
                const int msgn = (type == 1) ? 1 : (type == 2) ? -1 : 0;
#pragma unroll 1
                for (int st = 0; st < 4; ++st) {
                    bf16x8 kf[4];
#pragma unroll
                    for (int ks = 0; ks < 4; ++ks) kf[ks] = *(const LAS bf16x8*)(Ks + (32 * st + l31) * 144 + (16 * ks + 8 * hi) * 2);
                    u32x4 vf[2][2];
#pragma unroll
                    for (int dt = 0; dt < 2; ++dt)
#pragma unroll
                        for (int h2 = 0; h2 < 2; ++h2) {
                            const LAS unsigned char* vb = Vs + (32 * dt + l31) * 272 + (32 * st + 16 * h2 + 4 * hi) * 2;
                            const u32x2 b0 = *(const LAS u32x2*)vb, b1 = *(const LAS u32x2*)(vb + 16);
                            vf[dt][h2] = (u32x4){b0.x, b0.y, b1.x, b1.y};
                        }
#pragma unroll
                    for (int qt = 0; qt < 2; ++qt) {
                        const int a = qoff + 32 * qt + l31m;
                        f32x16 pp;
#pragma unroll
                        for (int r = 0; r < 16; ++r) pp[r] = 0.f;
#pragma unroll
                        for (int ks = 0; ks < 4; ++ks) pp = __builtin_amdgcn_mfma_f32_32x32x16_bf16(kf[ks], qop[qt][ks], pp, 0, 0, 0);
                        float ls = 0.f;
#pragma unroll
                        for (int r = 0; r < 16; ++r) { const int b = 32 * st + crow(r, him); const int dd = msgn * (b - a); const float e = __uint_as_float(__float_as_uint(__expf(pp[r])) & ~(unsigned)(dd >> 31)); pp[r] = e; ls += e; }
                        lsum[qt] += ls;
                        u32x4 pa[2];
#pragma unroll
                        for (int h2 = 0; h2 < 2; ++h2) { pa[h2].x = pk2(pp[8 * h2 + 0], pp[8 * h2 + 1]); pa[h2].y = pk2(pp[8 * h2 + 2], pp[8 * h2 + 3]); pa[h2].z = pk2(pp[8 * h2 + 4], pp[8 * h2 + 5]); pa[h2].w = pk2(pp[8 * h2 + 6], pp[8 * h2 + 7]); }
#pragma unroll
                        for (int dt = 0; dt < 2; ++dt)
#pragma unroll
                            for (int h2 = 0; h2 < 2; ++h2)
                                o[qt][dt] = __builtin_amdgcn_mfma_f32_32x32x16_bf16(__builtin_bit_cast(bf16x8, pa[h2]), __builtin_bit_cast(bf16x8, vf[dt][h2]), o[qt][dt], 0, 0, 0);
                    }
                }
            }
        }
        const float esink = __expf(sink[qh]);
#pragma unroll
        for (int qt = 0; qt < 2; ++qt) {
            float ltot = lsum[qt] + __shfl_xor(lsum[qt], 32);
            const float inv = 1.0f / (ltot + esink);
#pragma unroll
            for (int r = 0; r < 16; ++r) {
                const int qr = crow(r, hi); const float iv = __shfl(inv, qr);
                bf16* op = AO + (size_t)(rb + qoff + 32 * qt + qr) * 1024 + 64 * qh + l31;
                op[0] = (bf16)(pk2(o[qt][0][r] * iv, 0.f) & 0xffffu); op[32] = (bf16)(pk2(o[qt][1][r] * iv, 0.f) & 0xffffu);
            }
        }
    }
}

__device__ __forceinline__ float log_sigmoid_f(float x) { return -log1pf(__expf(-x)); }
struct ScanCtx { int h, dir, sl; float lg; bool active; };
__device__ __forceinline__ void scan_part(const LP& p, const ScanCtx& sc, int part, LAS unsigned char* lds) {
    int tid = threadIdx.x; asm volatile("" : "+v"(tid));
    const int lane = tid & 63, wave = tid >> 6, l31 = lane & 31, hi = lane >> 5, l15 = lane & 15, kq = lane >> 4;
    const bf16* Q = (const bf16*)(p.ws() + WS_RQ); const bf16* KT = (const bf16*)(p.ws() + WS_RKT); const bf16* VT = (const bf16*)(p.ws() + WS_RVT);
    bf16* OI = (bf16*)(p.ws() + WS_ROI); bf16* OIC = (bf16*)(p.ws() + WS_ROIC) + (size_t)sc.dir * 256 * 2048;
    LAS unsigned char* KTl = lds; LAS unsigned char* VTl = lds + 69632; LAS unsigned char* Stl = lds + 69632 + 8704;
    const int h = sc.h, dir = sc.dir, sl = sc.sl; const float lg = sc.lg;
    const float cd = __expf(lg * 128.0f);
    const int nsteps = (part == 0) ? 66 : 64;
    LAS float* kdt = (LAS float*)(lds + 96768); LAS float* qdt = (LAS float*)(lds + 97280);
    if (tid < 128) { const int m = tid; kdt[m] = __expf(lg * (float)(dir ? m : 127 - m)); qdt[m] = __expf(lg * (float)(dir ? 128 - m : m + 1)); }
    u32x4 vreg; bf16x8 kop[8], qA[8], qB[8];
#define SCAN_RB(s) (((part) == 0) ? (((s) < 2) ? (T_ + 128 * (dir ? 1 - (s) : (s))) : 128 * (dir ? 127 - ((s) - 2) : ((s) - 2))) : 128 * (dir ? 63 - (s) : 64 + (s)))
#define SCAN_LOAD_QV(rbv, QN) do { \
        const bf16* vb_ = VT + ((size_t)((rbv) >> 7) * 2048 + 512 * h + 32 * sl) * 128; const bf16* qb_ = Q + (((size_t)((rbv) >> 7) * 4 + h) * 8 + wave) * 4096; \
        vreg = __builtin_nontemporal_load((const u32x4*)(vb_ + koff)); \
        _Pragma("unroll") for (int ks = 0; ks < 8; ++ks) QN[ks] = *(const bf16x8*)(qb_ + ks * 512 + 8 * lane); } while (0)
#define SCAN_LOAD_K(rbv) do { \
        const bf16* kb_ = KT + (((size_t)((rbv) >> 7) * 4 + h) * 8 + wave) * 4096; \
        _Pragma("unroll") for (int ks = 0; ks < 8; ++ks) kop[ks] = *(const bf16x8*)(kb_ + ks * 512 + 8 * lane); } while (0)
    const int koff = (tid >> 4) * 128 + 8 * (tid & 15), qoff = (16 * wave + l15) * 1024 + 8 * kq;
    if (!sc.active) return;
    float* Ssave = (float*)(p.ws() + WS_ROIC + 2 * MiB) + (size_t)(sc.h + 4 * sc.dir + 8 * sc.sl) * 8192 + (size_t)tid * 16;
    f32x16 S;
    if (part == 0) {
#pragma unroll
        for (int r = 0; r < 16; ++r) S[r] = 0.f;
    } else {
#pragma unroll
        for (int r = 0; r < 4; ++r) { const f32x4 t = *(const f32x4*)(Ssave + 4 * r); S[4 * r] = t[0]; S[4 * r + 1] = t[1]; S[4 * r + 2] = t[2]; S[4 * r + 3] = t[3]; }
    }
    LAS int* rbtab = (LAS int*)(lds + 96256);
    if (tid <= nsteps) { const int st_ = (tid < nsteps) ? tid : nsteps - 1; rbtab[tid] = SCAN_RB(st_); }
    __syncthreads();
    { const int rb0 = rfl_i(rbtab[0]); SCAN_LOAD_QV(rb0, qA); SCAN_LOAD_K(rb0); }
    float pend[2][4] = {{0.f, 0.f, 0.f, 0.f}, {0.f, 0.f, 0.f, 0.f}}; unsigned short oiv[2][4] = {{0, 0, 0, 0}, {0, 0, 0, 0}};
    typedef __attribute__((address_space(1))) unsigned short g16;
    g16* const WSB = (g16*)p.ws();
    const int ooff = (16 * wave + 4 * kq) * 2048 + 512 * h + 32 * sl + l15;
    size_t pbu = (WS_ROIC + 6 * MiB) / 2;
#define SCAN_FLUSH() do { { \
        _Pragma("unroll") for (int nt = 0; nt < 2; ++nt) _Pragma("unroll") for (int jj = 0; jj < 4; ++jj) { \
            float v = pend[nt][jj]; v += (part == 1) ? bf2f(oiv[nt][jj]) : 0.f; (WSB + pbu + jj * 2048 + 16 * nt)[ooff] = (unsigned short)(pk2(v, 0.f) & 0xffffu); } } } while (0)
#define SCAN_STEP(SIDX, QC, QN) do { const int s = (SIDX); \
        const int rb = rfl_i(rbtab[s]); \
        { const int e = tid >> 4, pc = tid & 15; u32x4 w; const f32x4 kda = *(const LAS f32x4*)(kdt + 8 * pc), kdb = *(const LAS f32x4*)(kdt + 8 * pc + 4); const float kd[8] = {kda[0], kda[1], kda[2], kda[3], kdb[0], kdb[1], kdb[2], kdb[3]}; \
          w.x = pk2(__uint_as_float(vreg.x << 16) * kd[0], __uint_as_float(vreg.x & 0xffff0000u) * kd[1]); \
          w.y = pk2(__uint_as_float(vreg.y << 16) * kd[2], __uint_as_float(vreg.y & 0xffff0000u) * kd[3]); \
          w.z = pk2(__uint_as_float(vreg.z << 16) * kd[4], __uint_as_float(vreg.z & 0xffff0000u) * kd[5]); \
          w.w = pk2(__uint_as_float(vreg.w << 16) * kd[6], __uint_as_float(vreg.w & 0xffff0000u) * kd[7]); \
          *(LAS u32x4*)(VTl + e * 272 + 16 * pc) = w; } \
        _Pragma("unroll") for (int g4 = 0; g4 < 4; ++g4) { u32x2 w; w.x = pk2(S[4 * g4 + 0], S[4 * g4 + 1]); w.y = pk2(S[4 * g4 + 2], S[4 * g4 + 3]); \
            *(LAS u32x2*)(Stl + l31 * 528 + (32 * wave + 8 * g4 + 4 * hi) * 2) = w; } \
        SCAN_FLUSH(); \
        __syncthreads(); \
        const size_t obu = (rb >= T_) ? ((WS_ROIC / 2) + (size_t)dir * 256 * 2048 + (size_t)(rb - T_) * 2048) : ((WS_ROI / 2) + (size_t)rb * 2048); \
        _Pragma("unroll") for (int nt = 0; nt < 2; ++nt) _Pragma("unroll") for (int jj = 0; jj < 4; ++jj) oiv[nt][jj] = (WSB + obu + jj * 2048 + 16 * nt)[ooff]; \
        asm volatile("" ::: "memory"); \
        const int rbn = rfl_i(rbtab[s + 1]); \
        SCAN_LOAD_QV(rbn, QN); \
        __builtin_amdgcn_sched_barrier(0); \
        _Pragma("unroll") for (int r = 0; r < 16; ++r) S[r] *= cd; \
        { bf16x8 vb[8]; \
          _Pragma("unroll") for (int ks = 0; ks < 8; ++ks) vb[ks] = *(const LAS bf16x8*)(VTl + l31 * 272 + (16 * ks + 8 * hi) * 2); \
          __builtin_amdgcn_sched_barrier(0); \
          _Pragma("unroll") for (int ks = 0; ks < 8; ++ks) S = __builtin_amdgcn_mfma_f32_32x32x16_bf16(kop[ks], vb[ks], S, 0, 0, 0); } \
        __builtin_amdgcn_sched_barrier(0); \
        SCAN_LOAD_K(rbn); \
        __builtin_amdgcn_sched_barrier(0); \
        _Pragma("unroll") for (int nt = 0; nt < 2; ++nt) { \
            f32x4 acc = (f32x4){0.f, 0.f, 0.f, 0.f}; \
            { bf16x8 sb[8]; \
              _Pragma("unroll") for (int ks = 0; ks < 8; ++ks) sb[ks] = *(const LAS bf16x8*)(Stl + (16 * nt + l15) * 528 + (32 * ks + 8 * kq) * 2); \
              __builtin_amdgcn_sched_barrier(0); \
              _Pragma("unroll") for (int ks = 0; ks < 8; ++ks) acc = __builtin_amdgcn_mfma_f32_16x16x32_bf16(QC[ks], sb[ks], acc, 0, 0, 0); } \
            { const f32x4 qdv = *(const LAS f32x4*)(qdt + 16 * wave + 4 * kq); _Pragma("unroll") for (int jj = 0; jj < 4; ++jj) pend[nt][jj] = acc[jj] * qdv[jj]; } } \
        pbu = obu; \
        __syncthreads(); \
    } while (0)
    for (int s2 = 0; s2 < nsteps; s2 += 2) { SCAN_STEP(s2, qA, qB); SCAN_STEP(s2 + 1, qB, qA); }
    SCAN_FLUSH();
#undef SCAN_STEP
#undef SCAN_FLUSH
    if (part == 0) {
#pragma unroll
        for (int r = 0; r < 4; ++r) *(f32x4*)(Ssave + 4 * r) = (f32x4){S[4 * r], S[4 * r + 1], S[4 * r + 2], S[4 * r + 3]};
    }
#undef SCAN_RB
#undef SCAN_LOAD
}

__device__ __forceinline__ void phase_ret_intra(const LP& p, int j, LAS unsigned char* lds, int ubeg, int uend, int bidx, int bstride) {
    const bf16* Q = (const bf16*)(p.ws() + WS_RQ); const bf16* K = (const bf16*)(p.ws() + WS_RK); const bf16* VT = (const bf16*)(p.ws() + WS_RVT);
    bf16* G = (bf16*)(p.ws() + WS_RG); const bf16* OI = (const bf16*)(p.ws() + WS_ROI); const bf16* OIC = (const bf16*)(p.ws() + WS_ROIC);
    LAS unsigned char* Kl = lds; LAS unsigned char* Vl = lds + 67584;
    for (int u = ubeg + bidx; u < uend; u += bstride) {
        int tid = threadIdx.x; asm volatile("" : "+v"(tid));
        const int lane = tid & 63, wave = tid >> 6, l15 = lane & 15, kq = lane >> 4;
        const int c = u >> 2, h = u & 3; const int rb = 128 * c;
        const float lgf = log_sigmoid_f(p.in(15)[j * 4 + h]), lgb = log_sigmoid_f(p.in(16)[j * 4 + h]);
        __syncthreads();
        u32x4 kst[8];
#pragma unroll
        for (int i = 0; i < 8; ++i) { const int pid = tid + 512 * i; const int key = pid >> 5, pc = pid & 31; kst[i] = *(const u32x4*)(K + (size_t)(rb + key) * 1024 + 256 * h + 8 * pc); }
        __builtin_amdgcn_sched_barrier(0);
#pragma unroll
        for (int i = 0; i < 8; ++i) { const int pid = tid + 512 * i; const int key = pid >> 5, pc = pid & 31; *(LAS u32x4*)(Kl + key * 528 + 16 * pc) = kst[i]; }
        bf16x8 qop[8];
#pragma unroll
        for (int ks = 0; ks < 8; ++ks) qop[ks] = *(const bf16x8*)(Q + ((((size_t)(rb >> 7) * 4 + h) * 8 + wave) * 8 + ks) * 512 + 8 * lane);
        __syncthreads();
        u32x2 pk[8];
        const int mq = 16 * wave + l15;
#pragma unroll
        for (int kt = 0; kt < 8; ++kt) {
            f32x4 acc = (f32x4){0.f, 0.f, 0.f, 0.f}; bf16x8 ka[8];
#pragma unroll
            for (int ks = 0; ks < 8; ++ks) ka[ks] = *(const LAS bf16x8*)(Kl + (16 * kt + l15) * 528 + (32 * ks + 8 * kq) * 2);
            __builtin_amdgcn_sched_barrier(0);
#pragma unroll
            for (int ks = 0; ks < 8; ++ks) acc = __builtin_amdgcn_mfma_f32_16x16x32_bf16(ka[ks], qop[ks], acc, 0, 0, 0);
            float pv[4];
#pragma unroll
            for (int jj = 0; jj < 4; ++jj) { const int key = 16 * kt + 4 * kq + jj; const int rel = mq - key;
                const float dcy = (rel > 0) ? __expf(lgf * (float)rel) : (rel < 0) ? __expf(-lgb * (float)rel) : 2.0f; pv[jj] = acc[jj] * dcy; }
            pk[kt].x = pk2(pv[0], pv[1]); pk[kt].y = pk2(pv[2], pv[3]);
        }
        bf16* TMP = (rb >= T_) ? (bf16*)OIC + (size_t)(rb - T_) * 2048 : (bf16*)OI + (size_t)rb * 2048;
        const bool isc = rb >= T_;
        LAS float* Ol = (LAS float*)Kl;
        const int prow = tid >> 2, pseg = tid & 3;
        bf16* TMPr = TMP + (size_t)prow * 2048 + 512 * h;
        float ssp = 0.f;
#pragma unroll 1
        for (int es = 0; es < 4; ++es) {
            __syncthreads();
            u32x4 vst[4];
#pragma unroll
            for (int i = 0; i < 4; ++i) { const int pid = tid + 512 * i; const int e = pid >> 4, pc = pid & 15; vst[i] = *(const u32x4*)(VT + ((size_t)(rb >> 7) * 2048 + 512 * h + 128 * es + e) * 128 + 8 * pc); }
            __builtin_amdgcn_sched_barrier(0);
#pragma unroll
            for (int i = 0; i < 4; ++i) { const int pid = tid + 512 * i; const int e = pid >> 4, pc = pid & 15; *(LAS u32x4*)(Vl + e * 272 + 16 * pc) = vst[i]; }
            __syncthreads();
#pragma unroll
            for (int nt = 0; nt < 8; ++nt) {
                f32x4 acc = (f32x4){0.f, 0.f, 0.f, 0.f}; u32x4 bwv[4];
#pragma unroll
                for (int kp = 0; kp < 4; ++kp) {
                    const LAS unsigned char* vb = Vl + (16 * nt + l15) * 272 + (32 * kp + 4 * kq) * 2;
                    const u32x2 b0 = *(const LAS u32x2*)vb, b1 = *(const LAS u32x2*)(vb + 32);
                    bwv[kp] = (u32x4){b0.x, b0.y, b1.x, b1.y};
                }
                __builtin_amdgcn_sched_barrier(0);
#pragma unroll
                for (int kp = 0; kp < 4; ++kp) {
                    const u32x4 aw = (u32x4){pk[2 * kp].x, pk[2 * kp].y, pk[2 * kp + 1].x, pk[2 * kp + 1].y};
                    acc = __builtin_amdgcn_mfma_f32_16x16x32_bf16(__builtin_bit_cast(bf16x8, aw), __builtin_bit_cast(bf16x8, bwv[kp]), acc, 0, 0, 0);
                }
#pragma unroll
                for (int jj = 0; jj < 4; ++jj) Ol[(16 * wave + 4 * kq + jj) * 132 + 16 * nt + l15] = acc[jj];
            }
            __syncthreads();
            u32x4 oiq[4], ojq[4];
#pragma unroll
            for (int q = 0; q < 4; ++q) { const bf16* tp0 = TMPr + 128 * es + 32 * pseg + 8 * q; oiq[q] = *(const u32x4*)tp0; ojq[q] = (u32x4){0u, 0u, 0u, 0u}; if (isc) ojq[q] = *(const u32x4*)(tp0 + (size_t)256 * 2048); }
            __builtin_amdgcn_sched_barrier(0);
#pragma unroll
            for (int q = 0; q < 4; ++q) {
                const int e0 = 32 * pseg + 8 * q; bf16* tp = TMPr + 128 * es + e0;
                const u32x4 oi = oiq[q];
                const u32x4 oj = ojq[q];
                const f32x4 o0 = *(const LAS f32x4*)(Ol + prow * 132 + e0), o1 = *(const LAS f32x4*)(Ol + prow * 132 + e0 + 4);
                float v[8];
                v[0] = o0[0] + __uint_as_float(oi.x << 16) + __uint_as_float(oj.x << 16); v[1] = o0[1] + __uint_as_float(oi.x & 0xffff0000u) + __uint_as_float(oj.x & 0xffff0000u);
                v[2] = o0[2] + __uint_as_float(oi.y << 16) + __uint_as_float(oj.y << 16); v[3] = o0[3] + __uint_as_float(oi.y & 0xffff0000u) + __uint_as_float(oj.y & 0xffff0000u);
                v[4] = o1[0] + __uint_as_float(oi.z << 16) + __uint_as_float(oj.z << 16); v[5] = o1[1] + __uint_as_float(oi.z & 0xffff0000u) + __uint_as_float(oj.z & 0xffff0000u);
                v[6] = o1[2] + __uint_as_float(oi.w << 16) + __uint_as_float(oj.w << 16); v[7] = o1[3] + __uint_as_float(oi.w & 0xffff0000u) + __uint_as_float(oj.w & 0xffff0000u);
#pragma unroll
                for (int e = 0; e < 8; ++e) ssp += v[e] * v[e];
                u32x4 w; w.x = pk2(v[0], v[1]); w.y = pk2(v[2], v[3]); w.z = pk2(v[4], v[5]); w.w = pk2(v[6], v[7]);
                *(u32x4*)tp = w;
            }
        }
        ssp += __shfl_xor(ssp, 1); ssp += __shfl_xor(ssp, 2);
        const float rstd = rsqrtf(ssp * (1.0f / 512.0f) + 1e-6f);
        bf16* Gr = G + (size_t)(rb + prow) * 2048 + 512 * h;
#pragma unroll
        for (int es = 0; es < 4; ++es) {
            u32x4 tvq[4], gvq[4];
#pragma unroll
            for (int q = 0; q < 4; ++q) { const int col = 128 * es + 32 * pseg + 8 * q; tvq[q] = *(const u32x4*)(TMPr + col); gvq[q] = *(const u32x4*)(Gr + col); }
            __builtin_amdgcn_sched_barrier(0);
#pragma unroll
            for (int q = 0; q < 4; ++q) {
                const int col = 128 * es + 32 * pseg + 8 * q;
                const u32x4 tv = tvq[q], gv = gvq[q];
                u32x4 w;
                w.x = pk2(__uint_as_float(tv.x << 16) * rstd * __uint_as_float(gv.x << 16), __uint_as_float(tv.x & 0xffff0000u) * rstd * __uint_as_float(gv.x & 0xffff0000u));
                w.y = pk2(__uint_as_float(tv.y << 16) * rstd * __uint_as_float(gv.y << 16), __uint_as_float(tv.y & 0xffff0000u) * rstd * __uint_as_float(gv.y & 0xffff0000u));
                w.z = pk2(__uint_as_float(tv.z << 16) * rstd * __uint_as_float(gv.z << 16), __uint_as_float(tv.z & 0xffff0000u) * rstd * __uint_as_float(gv.z & 0xffff0000u));
                w.w = pk2(__uint_as_float(tv.w << 16) * rstd * __uint_as_float(gv.w << 16), __uint_as_float(tv.w & 0xffff0000u) * rstd * __uint_as_float(gv.w & 0xffff0000u));
                *(u32x4*)(Gr + col) = w;
            }
        }
    }
}

#define XB_TMO      128
#define XB_XCNT(j)  (256  + 64 * (j))
#define XB_XSUB(j)  (1280 + 64 * (j))
#define XB_XGEN(j)  (2304 + 64 * (j))
#define XB_TOP      3328
#define XB_TOPGEN   3392
#define XCD_BAR_WORDS 3456
#define XB_SPIN_CAP (1u << 18)

__device__ __forceinline__ unsigned xb_ld(unsigned* p)              { return __hip_atomic_load(p, __ATOMIC_RELAXED, __HIP_MEMORY_SCOPE_AGENT); }
__device__ __forceinline__ unsigned xb_add(unsigned* p, unsigned v) { return __hip_atomic_fetch_add(p, v, __ATOMIC_RELAXED, __HIP_MEMORY_SCOPE_AGENT); }
__device__ __forceinline__ unsigned xb_xcc_id() { return (unsigned)__builtin_amdgcn_s_getreg((3 << 11) | 20) & 0xFu; }
#define XB_SPIN(cond, bar) do { unsigned _sp = 0; while (cond) { __builtin_amdgcn_s_sleep(1); \
    if ((++_sp & 255u) == 0u) { if (xb_ld(&(bar)[XB_TMO])) break; if (_sp > XB_SPIN_CAP) { atomicAdd(&(bar)[XB_TMO], 1u); break; } } } } while (0)

struct XcdBarrier {
    unsigned* bar; unsigned x;
    volatile LAS unsigned* st;
};

__device__ __forceinline__ XcdBarrier xcd_barrier_post(unsigned* bar, volatile LAS unsigned* st) {
    XcdBarrier b; b.bar = bar; b.x = xb_xcc_id(); b.st = st;
    if (threadIdx.x == 0) (void)xb_add(&bar[XB_XCNT(b.x)], 1u);
    return b;
}
__device__ __forceinline__ void xcd_barrier_complete(unsigned* bar, unsigned x, unsigned& nloc, unsigned& nx) {
    const unsigned G = gridDim.x * gridDim.y * gridDim.z;
    unsigned sum, cnt, mine, sp = 0u;
    for (;;) {
        sum = 0u; cnt = 0u; mine = 0u;
#pragma unroll
        for (unsigned j = 0; j < 16; ++j) { const unsigned c = xb_ld(&bar[XB_XCNT(j)]); sum += c; cnt += (c > 0u) ? 1u : 0u; mine = (j == x) ? c : mine; }
        if (sum == G) break;
        __builtin_amdgcn_s_sleep(1);
        if ((++sp & 255u) == 0u) { if (xb_ld(&bar[XB_TMO])) break; if (sp > XB_SPIN_CAP) { atomicAdd(&bar[XB_TMO], 1u); break; } }
    }
    nloc = mine > 0u ? mine : 1u; nx = cnt > 0u ? cnt : 1u;
}

__device__ __forceinline__ void xcd_barrier(const XcdBarrier& b) {
    asm volatile("s_waitcnt vmcnt(0)" ::: "memory");
    __syncthreads();
    if (threadIdx.x == 0) {
        unsigned* bar = b.bar;
        __builtin_amdgcn_s_waitcnt(0);
        unsigned nloc = b.st[0], nx = b.st[1];
        if (nloc == 0u) { xcd_barrier_complete(bar, b.x, nloc, nx); b.st[0] = nloc; b.st[1] = nx; }
        const unsigned old = xb_add(&bar[XB_XSUB(b.x)], 1u);
        const unsigned gen = old / nloc;
        if (old + 1u == (gen + 1u) * nloc) {
            __builtin_amdgcn_fence(__ATOMIC_RELEASE, "agent");
            asm volatile("s_waitcnt vmcnt(0)" ::: "memory");
            const unsigned og = xb_add(&bar[XB_TOP], 1u);
            const unsigned tg = og / nx;
            if (og + 1u == (tg + 1u) * nx) xb_add(&bar[XB_TOPGEN], 1u);
            else XB_SPIN(xb_ld(&bar[XB_TOPGEN]) == tg, bar);
            __builtin_amdgcn_fence(__ATOMIC_ACQUIRE, "agent");
            xb_add(&bar[XB_XGEN(b.x)], 1u);
            asm volatile("s_waitcnt vmcnt(0)" ::: "memory");
        } else {
            XB_SPIN(xb_ld(&bar[XB_XGEN(b.x)]) == gen, bar);
            __builtin_amdgcn_fence(__ATOMIC_ACQUIRE, "agent");
            asm volatile("s_waitcnt vmcnt(0)" ::: "memory");
        }
    }
    __syncthreads();
}

constexpr int XBST_OFF = 131072 + 480;
__global__ void __launch_bounds__(NTHREADS, 2) fwd_megakernel(Params pin) {
    extern __shared__ __attribute__((aligned(16))) unsigned char lds_raw[];
    LAS unsigned char* lds = (LAS unsigned char*)lds_raw;
    cg::grid_group grid = cg::this_grid();
    {
        LAS unsigned long long* lp = (LAS unsigned long long*)(lds + PARAM_OFF);
        if (threadIdx.x < 25) lp[threadIdx.x] = (unsigned long long)pin.in[threadIdx.x];
        if (threadIdx.x == 25) lp[25] = (unsigned long long)pin.out;
        if (threadIdx.x == 26) lp[26] = (unsigned long long)pin.ws;
        __syncthreads();
    }
    LP p; p.q = (const LAS unsigned long long*)(lds + PARAM_OFF);
    if (threadIdx.x < 2) ((volatile LAS unsigned*)(lds + XBST_OFF))[threadIdx.x] = 0u;
    if (threadIdx.x == 0) {
        const unsigned x = xb_xcc_id();
        const unsigned r = __hip_atomic_fetch_add((unsigned*)(pin.ws + WS_BAR + 16384) + 64 * x, 1u, __ATOMIC_RELAXED, __HIP_MEMORY_SCOPE_AGENT);
        *(volatile LAS int*)(lds + VCU_OFF) = (int)(r * 16u + x);
    }
    __syncthreads();
    (void)xcd_barrier_post((unsigned*)(pin.ws + WS_BAR), (volatile LAS unsigned*)(lds + XBST_OFF));
#define GRID_BAR() do { XcdBarrier b_; b_.bar = (unsigned*)(p.ws() + WS_BAR); b_.x = xb_xcc_id(); b_.st = (volatile LAS unsigned*)(lds + XBST_OFF); xcd_barrier(b_); } while (0)
    { const float* cin = p.in(2); float* XC0 = (float*)(p.ws() + WS_XC);
      for (int i = blockIdx.x * NTHREADS + threadIdx.x; i < L_ * D_ / 4; i += gridDim.x * NTHREADS) ((f32x4*)XC0)[i] = ((const f32x4*)cin)[i]; }
    phase_adaln_partial(p);
    convert_mixer(p, 0, lds, (int)blockIdx.x, (int)gridDim.x);
    convert_ffn(p, 0, lds, (int)blockIdx.x, (int)gridDim.x);
    GRID_BAR();
    if (threadIdx.x == 0) {
        const unsigned* rw = (const unsigned*)(p.ws() + WS_BAR + 16384); const unsigned G = gridDim.x; bool ok = (G % 8u) == 0u;
        for (int jx = 0; jx < 8; ++jx) ok = ok && (__hip_atomic_load(rw + 64 * jx, __ATOMIC_RELAXED, __HIP_MEMORY_SCOPE_AGENT) == G / 8u);
        const int pk = *(volatile LAS int*)(lds + VCU_OFF); const int r = pk >> 4, x = pk & 15;
        *(volatile LAS int*)(lds + VCU_OFF) = (ok && x < 8) ? (r * 8 + x) : (int)blockIdx.x;
    }
    __syncthreads();
    phase_adaln_reduce(p);
    GRID_BAR();
    if (gridDim.x == 0x7fffffffu) grid.sync();
#pragma unroll 1
    for (int l = 0; l < 4; ++l) {
#pragma unroll 1
        for (int st = 0; st < 10; ++st) {
            const int kind = l % 3, j = l / 3;
            const bool isg = (st == 1) || (st == 2 && kind != 0) || st == 6 || st == 8 || st == 9;
            const bool did = !((st == 2 && kind == 0) || (st == 4 && kind != 1) || (st == 5 && kind != 1) || (st == 1 && kind != 0));
            if (isg) {
                if (threadIdx.x == 0) {
                    volatile LAS EpiD* e = (volatile LAS EpiD*)(lds + DESC_OFF);
                    unsigned char* ws = p.ws();
                    float* mods = (float*)(ws + WS_MODS); float* XC = (float*)(ws + WS_XC);
                    bf16* HX = (bf16*)(ws + WS_HX); bf16* WM = (bf16*)(ws + WS_WM); bf16* WF = (bf16*)(ws + WS_WF);
                    float* outp = p.out();
                    e->baseL = (l == 0) ? p.in(0) : outp; e->baseC = XC; e->outL = outp; e->outC = XC;
                    e->gateL = mods + (size_t)(l * 2 + 0) * 6144 + 2048; e->gateC = mods + (size_t)(l * 2 + 1) * 6144 + 2048;
                    e->ldc = 1024; e->part = (float*)(ws + WS_R + ((st == 9) ? 100 * MiB : 0));
                    if (st == 1) {
                        e->A = HX; e->Bt = WM; e->M = (l == 3) ? T_ : MT_; e->K = 1024;
                        if (kind == 0) { e->mode = EM_GLU; e->o0 = (bf16*)(ws + WS_Y1); e->bias = p.in(9) + j * 2048; e->N = 2048; }
                        else if (kind == 1) { e->mode = EM_RET; e->o0 = (bf16*)(ws + WS_RQ); e->o1 = (bf16*)(ws + WS_RG); e->o2 = (bf16*)(ws + WS_RK); e->N = 4096; }
                        else { e->mode = EM_ATT; e->o0 = (bf16*)(ws + WS_AQ); e->o1 = (bf16*)(ws + WS_AK); e->gq = p.in(19) + j * 64; e->gk = p.in(20) + j * 64; e->N = 1280; }
                    } else if (st == 2) {
                        e->Bt = HX; e->N = MT_; e->K = 1024;
                        if (kind == 1) { e->mode = EM_RETT; e->o0 = (bf16*)(ws + WS_RKT); e->o1 = (bf16*)(ws + WS_RVT); e->A = WM + (size_t)3072 * 1024; e->M = 3072; }
                        else { e->mode = EM_PLAIN; e->o0 = (bf16*)(ws + WS_AVT); e->ldc = 256; e->A = WM + (size_t)1280 * 1024; e->M = 256; }
                    } else if (st == 6) {
                        e->mode = EM_RES; e->M = (l >= 2) ? T_ : MT_; e->N = 1024;
                        if (kind == 0) { e->A = (const bf16*)(ws + WS_Y2); e->Bt = WM + 4 * MiB / 2; e->K = 1024; }
                        else if (kind == 1) { e->A = (const bf16*)(ws + WS_RG); e->Bt = WM + 12 * MiB / 2; e->K = 2048; }
                        else { e->A = (const bf16*)(ws + WS_AO); e->Bt = WM + 4 * MiB / 2; e->K = 1024; }
                    } else if (st == 8) { e->mode = EM_SWIGLU; e->o0 = (bf16*)(ws + WS_H); e->ldc = F_; e->A = HX; e->Bt = WF; e->M = (l >= 2) ? T_ : MT_; e->N = 2 * F_; e->K = 1024; }
                    else { e->mode = EM_RES; e->A = (const bf16*)(ws + WS_H); e->Bt = WF + 11 * MiB / 2; e->M = (l >= 2) ? T_ : MT_; e->N = 1024; e->K = F_;
                        e->baseL = outp; e->baseC = XC; e->gateL = mods + (size_t)(l * 2 + 0) * 6144 + 5120; e->gateC = mods + (size_t)(l * 2 + 1) * 6144 + 5120; }
                }
                __syncthreads();
                run_gemm(lds);
            } else if (st == 0) {
                float* XC = (float*)(p.ws() + WS_XC);
                phase_norm(p, l, false, (l == 0) ? p.in(0) : p.out(), XC, (const float*)(p.ws() + WS_R + 100 * MiB), (l == 0 || l == 3) ? 0 : 22); if (l > 0 && l != 1) convert_ffn(p, l, lds, (int)blockIdx.x, (int)gridDim.x);
            } else if (st == 7) {
                float* XC = (float*)(p.ws() + WS_XC);
                phase_norm(p, l, true, p.out(), XC, (const float*)(p.ws() + WS_R), (l >= 2) ? 0 : (kind == 1 ? 16 : 8)); if (l < 3 && l != 1) convert_mixer(p, l + 1, lds, (int)blockIdx.x, (int)gridDim.x);
            } else if (st == 3 || st == 4) {
                if (kind == 1) {
#ifndef NO_SCAN
                    ScanCtx sc; const int u = rfl_i(*(volatile LAS int*)(lds + VCU_OFF)); sc.active = u < 128; sc.h = u & 3; sc.dir = (u >> 2) & 1; sc.sl = (u >> 3) & 15;
                    sc.lg = log_sigmoid_f((sc.dir ? p.in(16) : p.in(15))[j * 4 + sc.h]);
                    scan_part(p, sc, st - 3, lds);
#endif
#ifndef NO_INTRA
                    if (st == 4 && u >= 128) phase_ret_intra(p, j, lds, 512, 520, u - 128, 128);
                    if (st == 3 && u >= 128) convert_ffn(p, l, lds, u - 128, (int)gridDim.x - 128);
                    if (st == 4 && u >= 136) { __syncthreads(); convert_mixer(p, l + 1, lds, u - 136, (int)gridDim.x - 136); }
#endif
                } else if (st == 3 && kind == 0) {
#ifndef NO_DW
                    phase_dwconv(p, j, (l == 3) ? T_ / 16 : MT_ / 16, lds);
#endif
                } else if (st == 3) {
#ifndef NO_ATTN
                    phase_attn(p, j, lds);
#endif
                }
            } else if (st == 5 && kind == 1) {
#ifndef NO_INTRA
                phase_ret_intra(p, j, lds, 0, 512, (int)blockIdx.x, (int)gridDim.x);
#endif
            }
            if (did) GRID_BAR();
        }
    }
}

extern "C" void kernel_launch(void* const* d_in, const int* in_sizes, int n_in, void* d_out, int out_size, void* d_ws, size_t ws_size, hipStream_t stream) {
    static int grid_blocks = 0;
    if (grid_blocks == 0) {
        if (n_in != 25 || ws_size < WS_END) { fprintf(stderr, "kernel_launch: unexpected n_in %d / ws_size %zu (need %zu)\n", n_in, ws_size, (size_t)WS_END); grid_blocks = -1; return; }
        int dev = 0, cus = 0, per_cu = 0;
        hipGetDevice(&dev);
        hipDeviceGetAttribute(&cus, hipDeviceAttributeMultiprocessorCount, dev);
        if (hipFuncSetAttribute((const void*)fwd_megakernel, hipFuncAttributeMaxDynamicSharedMemorySize, LDS_BYTES) != hipSuccess) { fprintf(stderr, "kernel_launch: hipFuncSetAttribute failed\n"); grid_blocks = -1; return; }
        hipOccupancyMaxActiveBlocksPerMultiprocessor(&per_cu, (const void*)fwd_megakernel, NTHREADS, LDS_BYTES);
        if (per_cu < 1) { fprintf(stderr, "kernel_launch: occupancy query gives %d\n", per_cu); per_cu = 1; }
        (void)hipGetLastError();
        grid_blocks = cus * 1;
        if (grid_blocks < 128) { fprintf(stderr, "kernel_launch: grid %d too small\n", grid_blocks); grid_blocks = -1; return; }
    }
    if (grid_blocks < 0) return;
    Params p{};
    for (int i = 0; i < 25; ++i) p.in[i] = (const float*)d_in[i];
    p.out = (float*)d_out; p.ws = (unsigned char*)d_ws;
    if (hipMemsetAsync((char*)d_ws + WS_BAR, 0, 32768, stream) != hipSuccess) { fprintf(stderr, "kernel_launch: memset failed\n"); return; }
    void* args[] = {&p};
    hipError_t e = hipLaunchCooperativeKernel((void*)fwd_megakernel, dim3(grid_blocks), dim3(NTHREADS), args, LDS_BYTES, stream);
    if (e != hipSuccess) fprintf(stderr, "cooperative launch failed: %s (grid %d)\n", hipGetErrorString(e), grid_blocks);
}
```
